# Optimizing an MI355X kernel written in HIP

```python
import math
import jax
import jax.numpy as jnp
from jax import lax
import numpy as np

D_MODEL = 1024
BATCH = 8
SEQ = 4096
DEPTH = 2

CTX_LEN = 256
GRID_W = 64
N_EVEN = (DEPTH + 1) // 2
N_ODD = DEPTH // 2
RMS_EPS = 1e-6
NEG_INF = -1e30
MOD_INIT = 0.5

SSD_HEADS = 16
SSD_HEAD_DIM = 64
SSD_INNER = SSD_HEADS * SSD_HEAD_DIM
SSD_GROUPS = 2
SSD_STATE = 128
SSD_CONV_W = 3
SSD_CHUNK = 128
DT_MIN = 0.001
DT_MAX = 0.1
SSD_GN = SSD_GROUPS * SSD_STATE

NA_HEADS = 16
NA_HEAD_DIM = 64
NA_INNER = NA_HEADS * NA_HEAD_DIM
NA_WIN_R = 8
NA_WIN_C = 16
NA_QBLOCK = 16
NA_KCOLS = 2 * NA_WIN_C

SC_INNER = D_MODEL
SC_CONV_W = 3

D_FF = 4 * D_MODEL

OFF_X = 0
OFF_B = OFF_X + SSD_INNER
OFF_DT = OFF_B + SSD_GN
OFF_K = OFF_DT + 2 * SSD_HEADS
OFF_V = OFF_K + NA_INNER
OFF_C = OFF_V + NA_INNER
OFF_Z = OFF_C + SSD_GN
OFF_Q = OFF_Z + SSD_INNER
IN0_COLS = OFF_Q + NA_INNER
CONV0_CH = SSD_INNER + 2 * SSD_GN

kernel_name = "hybrid_ssd_natten_shortconv_dit"


def rmsnorm(x, w):
    xf = x.astype(jnp.float32)
    xf = xf * lax.rsqrt(jnp.mean(xf * xf, axis=-1, keepdims=True) + RMS_EPS)
    return (xf * w.astype(jnp.float32)).astype(x.dtype)


def modulate(h, shift, scale):
    return h * (1 + scale) + shift


def dwconv_centred(u, w, b=None):
    width, ch = w.shape
    y = lax.conv_general_dilated(
        u, w[:, None, :].astype(u.dtype), window_strides=(1,),
        padding=[(width // 2, width // 2)],
        dimension_numbers=('NWC', 'WIO', 'NWC'), feature_group_count=ch)
    return y if b is None else y + b


def ssd_chunk_inputs(x, dt, A, bm):
    bsz, length, heads, hd = x.shape
    nc, rep = length // SSD_CHUNK, heads // SSD_GROUPS
    xdt = (x * dt[..., None]).reshape(bsz, nc, SSD_CHUNK, SSD_GROUPS, rep, hd)
    a_cum = jnp.cumsum((dt * A).reshape(bsz, nc, SSD_CHUNK, SSD_GROUPS, rep), axis=2)
    bc = bm.reshape(bsz, nc, SSD_CHUNK, SSD_GROUPS, SSD_STATE)
    return xdt, a_cum, bc


def ssd_carry(xdt, a_cum, bc, h0):
    to_end = jnp.exp(a_cum[:, :, -1:] - a_cum)
    chunk_states = jnp.einsum('bcqgn,bcqgrp->bcgrpn', bc, to_end[..., None] * xdt)
    chunk_decay = jnp.exp(a_cum[:, :, -1])

    def step(h, inp):
        s, dcy = inp
        return dcy[..., None, None] * h + s, h

    h_final, h_start = lax.scan(step, h0, (jnp.moveaxis(chunk_states, 1, 0), jnp.moveaxis(chunk_decay, 1, 0)))
    return jnp.moveaxis(h_start, 0, 1), h_final


def ssd_readout(xdt, a_cum, bc, cc, h_start):
    q = a_cum.shape[2]
    lower = jnp.tril(jnp.ones((q, q), dtype=bool))
    a_t = jnp.moveaxis(a_cum, 2, -1)
    seg = a_t[..., :, None] - a_t[..., None, :]
    decay = jnp.exp(jnp.where(lower, seg, -jnp.inf))
    cb = jnp.einsum('bcign,bcjgn->bcgij', cc, bc)
    y_diag = jnp.einsum('bcgrij,bcjgrp->bcigrp', cb[:, :, :, None] * decay, xdt)
    y_off = jnp.einsum('bcign,bcgrpn->bcigrp', cc, h_start) * jnp.exp(a_cum)[..., None]
    return y_diag + y_off


def bidirectional_ssd(x_l, b_l, c_l, dt_l, x_c, b_c, dt_c, dt_bias, a_log, d_skip):
    out_dtype = x_l.dtype
    f32 = jnp.float32
    x_l, b_l, c_l, x_c, b_c = (t.astype(f32) for t in (x_l, b_l, c_l, x_c, b_c))
    bsz, seq, heads, hd = x_l.shape
    rep = heads // SSD_GROUPS
    y = d_skip.astype(f32)[:, None] * x_l
    for d in range(2):
        rev = (lambda t: jnp.flip(t, axis=1)) if d == 1 else (lambda t: t)
        A = -jnp.exp(a_log[d].astype(f32))
        dtc = jax.nn.softplus(dt_c[:, :, d].astype(f32) + dt_bias[d].astype(f32))
        dtl = jax.nn.softplus(dt_l[:, :, d].astype(f32) + dt_bias[d].astype(f32))
        h0 = jnp.zeros((bsz, SSD_GROUPS, rep, hd, SSD_STATE), f32)
        _, h_ctx = ssd_carry(*ssd_chunk_inputs(rev(x_c), rev(dtc), A, rev(b_c)), h0)
        xdt, a_cum, bc = ssd_chunk_inputs(rev(x_l), rev(dtl), A, rev(b_l))
        h_start, _ = ssd_carry(xdt, a_cum, bc, h_ctx)
        cc = rev(c_l).reshape(bc.shape)
        y = y + rev(ssd_readout(xdt, a_cum, bc, cc, h_start).reshape(bsz, seq, heads, hd))
    return y.reshape(bsz, seq, heads * hd).astype(out_dtype)


def neighbourhood_attention(q, k, v, k_ctx, v_ctx, rpb):
    bsz, seq, heads, hd = q.shape
    rows = seq // GRID_W
    wr = min(NA_WIN_R, rows)
    n_blk = GRID_W // NA_QBLOCK
    qg = (q * hd ** -0.5).reshape(bsz, rows, GRID_W, heads, hd)
    kg = k.reshape(bsz, rows, GRID_W, heads, hd)
    vg = v.reshape(bsz, rows, GRID_W, heads, hd)

    q_col = jnp.arange(GRID_W).reshape(n_blk, NA_QBLOCK)
    kc0 = jnp.clip(jnp.arange(n_blk) * NA_QBLOCK - NA_WIN_C // 2, 0, GRID_W - NA_KCOLS)
    k_col = kc0[:, None] + jnp.arange(NA_KCOLS)
    win_start = jnp.clip(q_col - NA_WIN_C // 2, 0, GRID_W - NA_WIN_C)
    kcb = k_col[:, None, :]
    col_ok = (kcb >= win_start[..., None]) & (kcb < win_start[..., None] + NA_WIN_C)
    dc_idx = jnp.clip(kcb - q_col[..., None], -(NA_WIN_C - 1), NA_WIN_C - 1) + NA_WIN_C - 1
    rpb_c = rpb[:, :, dc_idx]
    n_win = wr * NA_KCOLS

    def row_fn(r):
        rs = jnp.clip(r - NA_WIN_R // 2, 0, rows - wr)
        k_win = lax.dynamic_slice_in_dim(kg, rs, wr, axis=1)[:, :, k_col]
        v_win = lax.dynamic_slice_in_dim(vg, rs, wr, axis=1)[:, :, k_col]
        q_r = lax.dynamic_index_in_dim(qg, r, axis=1, keepdims=False).reshape(bsz, n_blk, NA_QBLOCK, heads, hd)
        s_win = jnp.einsum('bjqhd,bwjkhd->bhjqwk', q_r, k_win).astype(jnp.float32)
        dr_idx = rs + jnp.arange(wr) - r + NA_WIN_R - 1
        bias = jnp.take(rpb_c, dr_idx, axis=1).transpose(0, 2, 3, 1, 4).astype(jnp.float32)
        s_win = jnp.where(col_ok[:, :, None, :], s_win + bias, NEG_INF)
        s_ctx = jnp.einsum('bjqhd,bchd->bhjqc', q_r, k_ctx).astype(jnp.float32)
        s = jnp.concatenate([s_win.reshape(bsz, heads, n_blk, NA_QBLOCK, n_win), s_ctx], axis=-1)
        p = jax.nn.softmax(s, axis=-1).astype(v.dtype)
        p_win = p[..., :n_win].reshape(bsz, heads, n_blk, NA_QBLOCK, wr, NA_KCOLS)
        o = (jnp.einsum('bhjqwk,bwjkhd->bjqhd', p_win, v_win)
             + jnp.einsum('bhjqc,bchd->bjqhd', p[..., n_win:], v_ctx))
        return o.reshape(bsz, GRID_W, heads * hd)

    out = lax.map(row_fn, jnp.arange(rows))
    return jnp.moveaxis(out, 0, 1).reshape(bsz, seq, heads * hd)


def ssd_na_mixer(h_lat, h_ctx, in_w, conv_w, conv_b, dt_bias, a_log, d_skip, norm_w, rpb, out_w):
    bsz, seq, _ = h_lat.shape
    n_ctx = h_ctx.shape[1]
    pc = h_ctx @ in_w[:, :OFF_C]
    xb_c = jax.nn.silu(dwconv_centred(pc[..., :OFF_DT], conv_w[:, :OFF_DT], conv_b[:OFF_DT]))
    x_c = xb_c[..., :SSD_INNER].reshape(bsz, n_ctx, SSD_HEADS, SSD_HEAD_DIM)
    b_c = xb_c[..., SSD_INNER:].reshape(bsz, n_ctx, SSD_GROUPS, SSD_STATE)
    dt_c = pc[..., OFF_DT:OFF_K].reshape(bsz, n_ctx, 2, SSD_HEADS)
    k_c = pc[..., OFF_K:OFF_V].reshape(bsz, n_ctx, NA_HEADS, NA_HEAD_DIM)
    v_c = pc[..., OFF_V:OFF_C].reshape(bsz, n_ctx, NA_HEADS, NA_HEAD_DIM)
    pl = h_lat @ in_w
    xbc = jax.nn.silu(dwconv_centred(
        jnp.concatenate([pl[..., :OFF_DT], pl[..., OFF_C:OFF_Z]], axis=-1), conv_w, conv_b))
    x_l = xbc[..., :SSD_INNER].reshape(bsz, seq, SSD_HEADS, SSD_HEAD_DIM)
    b_l = xbc[..., SSD_INNER:OFF_DT].reshape(bsz, seq, SSD_GROUPS, SSD_STATE)
    c_l = xbc[..., OFF_DT:].reshape(bsz, seq, SSD_GROUPS, SSD_STATE)
    dt_l = pl[..., OFF_DT:OFF_K].reshape(bsz, seq, 2, SSD_HEADS)
    k_l = pl[..., OFF_K:OFF_V].reshape(bsz, seq, NA_HEADS, NA_HEAD_DIM)
    v_l = pl[..., OFF_V:OFF_C].reshape(bsz, seq, NA_HEADS, NA_HEAD_DIM)
    z = pl[..., OFF_Z:OFF_Q]
    q_l = pl[..., OFF_Q:].reshape(bsz, seq, NA_HEADS, NA_HEAD_DIM)

    y_ssd = bidirectional_ssd(x_l, b_l, c_l, dt_l, x_c, b_c, dt_c, dt_bias, a_log, d_skip)
    y_ssd = rmsnorm(y_ssd * jax.nn.silu(z), norm_w)
    y_na = neighbourhood_attention(q_l, k_l, v_l, k_c, v_c, rpb)
    return jnp.concatenate([y_ssd.astype(y_na.dtype), y_na], axis=-1) @ out_w


def short_conv_mixer(h, in_w, conv_w, out_w):
    gate_b, gate_c, val = jnp.split(h @ in_w, 3, axis=-1)
    return (gate_b * dwconv_centred(gate_c * val, conv_w)) @ out_w


def sq_relu_mlp(h, w1, w2):
    return jnp.square(jax.nn.relu(h @ w1)) @ w2


def setup_inputs(seed: int = 0) -> dict:
    key = jax.random.key(seed)
    ks = jax.random.split(key, 23)
    D = D_MODEL
    nrm = jax.random.normal
    f32 = jnp.float32
    x = nrm(ks[0], (BATCH, SEQ, D), f32)
    c = nrm(ks[1], (BATCH, D), f32)
    ctx = nrm(ks[2], (BATCH, CTX_LEN, D), f32)
    c_ctx = nrm(ks[3], (D,), f32)
    mod_w = nrm(ks[4], (DEPTH, D, 6 * D), f32) * (MOD_INIT * D ** -0.5)
    mod_b = 0.02 * nrm(ks[5], (DEPTH, 6 * D), f32)
    norm_mix_w = 1.0 + 0.02 * nrm(ks[6], (DEPTH, D), f32)
    norm_mlp_w = 1.0 + 0.02 * nrm(ks[7], (DEPTH, D), f32)
    mlp_w1 = nrm(ks[8], (DEPTH, D, D_FF), f32) * D ** -0.5
    mlp_w2 = nrm(ks[9], (DEPTH, D_FF, D), f32) * D_FF ** -0.5
    ssdna_in_w = nrm(ks[10], (N_EVEN, D, IN0_COLS), f32) * D ** -0.5
    ssdna_conv_w = nrm(ks[11], (N_EVEN, SSD_CONV_W, CONV0_CH), f32) * SSD_CONV_W ** -0.5
    ssdna_conv_b = 0.02 * nrm(ks[12], (N_EVEN, CONV0_CH), f32)
    dt0 = jnp.exp(jax.random.uniform(ks[13], (N_EVEN, 2, SSD_HEADS), f32,
                                     minval=math.log(DT_MIN), maxval=math.log(DT_MAX)))
    ssd_dt_bias = dt0 + jnp.log(-jnp.expm1(-dt0))
    ssd_a_log = jnp.log(jax.random.uniform(ks[14], (N_EVEN, 2, SSD_HEADS), f32, minval=1.0, maxval=16.0))
    ssd_d = 1.0 + 0.02 * nrm(ks[15], (N_EVEN, SSD_HEADS), f32)
    ssd_norm_w = 1.0 + 0.02 * nrm(ks[16], (N_EVEN, SSD_INNER), f32)
    na_rpb = 0.02 * nrm(ks[17], (N_EVEN, NA_HEADS, 2 * NA_WIN_R - 1, 2 * NA_WIN_C - 1), f32)
    ssdna_out_w = nrm(ks[18], (N_EVEN, SSD_INNER + NA_INNER, D), f32) * (SSD_INNER + NA_INNER) ** -0.5
    sc_in_w = nrm(ks[19], (N_ODD, D, 3 * SC_INNER), f32) * D ** -0.5
    sc_conv_w = nrm(ks[20], (N_ODD, SC_CONV_W, SC_INNER), f32) * SC_CONV_W ** -0.5
    sc_out_w = nrm(ks[21], (N_ODD, SC_INNER, D), f32) * SC_INNER ** -0.5
    final_norm_w = 1.0 + 0.02 * nrm(ks[22], (D,), f32)
    return {"x": x, "c": c, "ctx": ctx, "c_ctx": c_ctx,
            "mod_w": mod_w, "mod_b": mod_b, "norm_mix_w": norm_mix_w, "norm_mlp_w": norm_mlp_w,
            "mlp_w1": mlp_w1, "mlp_w2": mlp_w2,
            "ssdna_in_w": ssdna_in_w, "ssdna_conv_w": ssdna_conv_w, "ssdna_conv_b": ssdna_conv_b,
            "ssd_dt_bias": ssd_dt_bias, "ssd_a_log": ssd_a_log, "ssd_d": ssd_d, "ssd_norm_w": ssd_norm_w,
            "na_rpb": na_rpb, "ssdna_out_w": ssdna_out_w,
            "sc_in_w": sc_in_w, "sc_conv_w": sc_conv_w, "sc_out_w": sc_out_w,
            "final_norm_w": final_norm_w}


def reference(x, c, ctx, c_ctx, mod_w, mod_b, norm_mix_w, norm_mlp_w, mlp_w1, mlp_w2,
              ssdna_in_w, ssdna_conv_w, ssdna_conv_b, ssd_dt_bias, ssd_a_log, ssd_d, ssd_norm_w,
              na_rpb, ssdna_out_w, sc_in_w, sc_conv_w, sc_out_w, final_norm_w):
    D = D_MODEL
    for i in range(DEPTH):
        mod = jax.nn.silu(c) @ mod_w[i] + mod_b[i]
        shift_a, scale_a, gate_a, shift_f, scale_f, gate_f = jnp.split(mod[:, None, :], 6, axis=-1)
        h = modulate(rmsnorm(x, norm_mix_w[i]), shift_a, scale_a)
        if i % 2 == 0:
            e = i // 2
            mod_ctx = jax.nn.silu(c_ctx) @ mod_w[i][:, :2 * D] + mod_b[i][:2 * D]
            h_ctx = modulate(rmsnorm(ctx, norm_mix_w[i]), mod_ctx[:D], mod_ctx[D:])
            y = ssd_na_mixer(h, h_ctx, ssdna_in_w[e], ssdna_conv_w[e], ssdna_conv_b[e], ssd_dt_bias[e],
                             ssd_a_log[e], ssd_d[e], ssd_norm_w[e], na_rpb[e], ssdna_out_w[e])
        else:
            o = i // 2
            y = short_conv_mixer(h, sc_in_w[o], sc_conv_w[o], sc_out_w[o])
        x = x + gate_a * y
        h = modulate(rmsnorm(x, norm_mlp_w[i]), shift_f, scale_f)
        x = x + gate_f * sq_relu_mlp(h, mlp_w1[i], mlp_w2[i])
    return rmsnorm(x, final_norm_w)
```

```cpp
#include <hip/hip_runtime.h>
#include <cstdio>
#include <cstdint>

namespace {
constexpr int D = 1024, BATCH = 8, SEQ = 4096, CTX = 256, GW = 64, ROWS = SEQ / GW;
constexpr int SSD_H = 16, SSD_P = 64, SSD_N = 128, SSD_G = 2, GN = 256;
constexpr int NA_H = 16, NA_D = 64;
constexpr int DFF = 4096;
constexpr int OFF_X = 0, OFF_B = 1024, OFF_DT = 1280, OFF_K = 1312, OFF_V = 2336, OFF_C = 3360, OFF_Z = 3616, OFF_Q = 4640, IN0 = 5664;
constexpr int CONV0 = 1536;
constexpr float EPS = 1e-6f;

__device__ __forceinline__ float silu_f(float v) { return v / (1.f + __expf(-v)); }
__device__ __forceinline__ float softplus_f(float v) { return fmaxf(v, 0.f) + log1pf(__expf(-fabsf(v))); }

__global__ void k_mod(const float* c, const float* cctx, const float* mod_w, const float* mod_b, float* mod, float* modctx) {
    int idx = blockIdx.x * blockDim.x + threadIdx.x;
    const int NM = 2 * BATCH * 6 * D;
    if (idx < NM) {
        int n = idx % (6 * D), b = (idx / (6 * D)) % BATCH, i = idx / (6 * D * BATCH);
        const float* w = mod_w + (size_t)i * D * 6 * D + n;
        float acc = 0.f;
        for (int k = 0; k < D; ++k) acc += silu_f(c[b * D + k]) * w[(size_t)k * 6 * D];
        mod[idx] = acc + mod_b[i * 6 * D + n];
    } else if (idx < NM + 2 * D) {
        int n = idx - NM;
        const float* w = mod_w + n;
        float acc = 0.f;
        for (int k = 0; k < D; ++k) acc += silu_f(cctx[k]) * w[(size_t)k * 6 * D];
        modctx[n] = acc + mod_b[n];
    }
}

__global__ void k_norm(const float* x, const float* w, const float* shift, const float* scale, float* out) {
    __shared__ float red[4];
    const int row = blockIdx.x, tid = threadIdx.x;
    const float* xr = x + (size_t)row * D;
    float v[4]; float s = 0.f;
    for (int j = 0; j < 4; ++j) { v[j] = xr[tid + 256 * j]; s += v[j] * v[j]; }
    for (int o = 32; o > 0; o >>= 1) s += __shfl_xor(s, o);
    if ((tid & 63) == 0) red[tid >> 6] = s;
    __syncthreads();
    s = red[0] + red[1] + red[2] + red[3];
    const float rstd = rsqrtf(s / D + EPS);
    for (int j = 0; j < 4; ++j) { int cidx = tid + 256 * j; float h = v[j] * rstd * w[cidx];
        if (scale) h = h * (1.f + scale[cidx]) + shift[cidx];
        out[(size_t)row * D + cidx] = h; }
}

__global__ void __launch_bounds__(256) k_gemm(const float* A, int lda, const float* W, int ldw, float* C, int ldc, int M, int N, int K,
                                              int mode, const float* resid, int ldr, const float* gate) {
    __shared__ float As[16][65];
    __shared__ float Ws[16][65];
    const int tx = threadIdx.x & 15, ty = threadIdx.x >> 4;
    const int m0 = blockIdx.y * 64, n0 = blockIdx.x * 64;
    float acc[4][4];
    for (int i = 0; i < 4; ++i) for (int j = 0; j < 4; ++j) acc[i][j] = 0.f;
    for (int k0 = 0; k0 < K; k0 += 16) {
        for (int e = threadIdx.x; e < 64 * 16; e += 256) { int r = e >> 4, kk = e & 15; As[kk][r] = A[(size_t)(m0 + r) * lda + k0 + kk]; }
        for (int e = threadIdx.x; e < 64 * 16; e += 256) { int kk = e >> 6, cc = e & 63; int n = n0 + cc; Ws[kk][cc] = n < N ? W[(size_t)(k0 + kk) * ldw + n] : 0.f; }
        __syncthreads();
#pragma unroll
        for (int kk = 0; kk < 16; ++kk) {
            float a[4], b[4];
            for (int i = 0; i < 4; ++i) a[i] = As[kk][ty * 4 + i];
            for (int j = 0; j < 4; ++j) b[j] = Ws[kk][tx + 16 * j];
            for (int i = 0; i < 4; ++i) for (int j = 0; j < 4; ++j) acc[i][j] += a[i] * b[j];
        }
        __syncthreads();
    }
    for (int i = 0; i < 4; ++i) for (int j = 0; j < 4; ++j) {
        int m = m0 + ty * 4 + i, n = n0 + tx + 16 * j;
        if (n < N) { float v = acc[i][j];
            if (mode == 1) v = resid[(size_t)m * ldr + n] + gate[n] * v;
            else if (mode == 2) { v = fmaxf(v, 0.f); v = v * v; }
            C[(size_t)m * ldc + n] = v; }
    }
}

__global__ void k_conv0(const float* src, int lds_, int L, int nch, const float* cw, const float* cb, float* dst, int latent) {
    int idx = blockIdx.x * blockDim.x + threadIdx.x;
    if (idx >= L * nch) return;
    int t = idx / nch, ch = idx % nch;
    int col = (ch < 1280) ? ch : (OFF_C + ch - 1280);
    float a = 0.f;
    for (int k = 0; k < 3; ++k) { int tt = t + k - 1; if (tt >= 0 && tt < L) a += cw[k * CONV0 + ch] * src[(size_t)tt * lds_ + col]; }
    a += cb[ch];
    dst[(size_t)t * CONV0 + ch] = silu_f(a);
}

__global__ void __launch_bounds__(64) k_ssd(const float* xbc_c, const float* pc, const float* xbc_l, const float* pl,
                                            const float* dt_bias, const float* a_log, const float* dskip, float* yout  ) {
    const int dir = blockIdx.x >> 4, h = blockIdx.x & 15, p = threadIdx.x, g = h >> 3;
    const float A = -__expf(a_log[dir * 16 + h]), bias = dt_bias[dir * 16 + h];
    float st[SSD_N];
#pragma unroll
    for (int n = 0; n < SSD_N; ++n) st[n] = 0.f;
    for (int step = 0; step < CTX; ++step) {
        const int t = dir ? (CTX - 1 - step) : step;
        const float dtv = softplus_f(pc[(size_t)t * OFF_C + OFF_DT + dir * 16 + h] + bias);
        const float dA = __expf(dtv * A);
        const float xv = xbc_c[(size_t)t * CONV0 + h * 64 + p] * dtv;
        const float* Bt = xbc_c + (size_t)t * CONV0 + 1024 + g * 128;
#pragma unroll
        for (int n = 0; n < SSD_N; ++n) st[n] = dA * st[n] + Bt[n] * xv;
    }
    float* yo = yout + (size_t)dir * SEQ * 1024;
    for (int step = 0; step < SEQ; ++step) {
        const int t = dir ? (SEQ - 1 - step) : step;
        const float dtv = softplus_f(pl[(size_t)t * IN0 + OFF_DT + dir * 16 + h] + bias);
        const float dA = __expf(dtv * A);
        const float xr = xbc_l[(size_t)t * CONV0 + h * 64 + p];
        const float xv = xr * dtv;
        const float* Bt = xbc_l + (size_t)t * CONV0 + 1024 + g * 128;
        const float* Ct = xbc_l + (size_t)t * CONV0 + 1280 + g * 128;
        float y = 0.f;
#pragma unroll
        for (int n = 0; n < SSD_N; ++n) { st[n] = dA * st[n] + Bt[n] * xv; y += Ct[n] * st[n]; }
        if (dir == 0) y += dskip[h] * xr;
        yo[(size_t)t * 1024 + h * 64 + p] = y;
    }
}

__global__ void k_gate(const float* y2, const float* pl, const float* w, float* ycat) {
    __shared__ float red[4];
    const int t = blockIdx.x, tid = threadIdx.x;
    float v[4]; float s = 0.f;
    for (int j = 0; j < 4; ++j) { int cidx = tid + 256 * j;
        float y = y2[(size_t)t * 1024 + cidx] + y2[(size_t)SEQ * 1024 + (size_t)t * 1024 + cidx];
        float z = pl[(size_t)t * IN0 + OFF_Z + cidx];
        v[j] = y * silu_f(z); s += v[j] * v[j]; }
    for (int o = 32; o > 0; o >>= 1) s += __shfl_xor(s, o);
    if ((tid & 63) == 0) red[tid >> 6] = s;
    __syncthreads();
    s = red[0] + red[1] + red[2] + red[3];
    const float rstd = rsqrtf(s / 1024.f + EPS);
    for (int j = 0; j < 4; ++j) { int cidx = tid + 256 * j; ycat[(size_t)t * 2048 + cidx] = v[j] * rstd * w[cidx]; }
}

__global__ void __launch_bounds__(64) k_na(const float* pl, const float* pc, const float* rpb, float* ycat) {
    const int idx = blockIdx.x * 64 + threadIdx.x;
    const int t = idx >> 4, h = idx & 15;
    const int r = t / GW, cq = t % GW;
    float q[64], acc[64];
    const float* qp = pl + (size_t)t * IN0 + OFF_Q + h * 64;
#pragma unroll
    for (int d = 0; d < 64; ++d) { q[d] = qp[d] * 0.125f; acc[d] = 0.f; }
    float m = -1e30f, l = 0.f;
    const int rs = min(max(r - 4, 0), ROWS - 8), ws = min(max(cq - 8, 0), GW - 16);
    for (int key = 0; key < 128 + CTX; ++key) {
        const float* kp; const float* vp; float bias = 0.f;
        if (key < 128) { int kr = rs + (key >> 4), kc = ws + (key & 15); int tk = kr * GW + kc;
            kp = pl + (size_t)tk * IN0 + OFF_K + h * 64; vp = pl + (size_t)tk * IN0 + OFF_V + h * 64;
            bias = rpb[(h * 15 + (kr - r + 7)) * 31 + (kc - cq + 15)]; }
        else { int cidx = key - 128; kp = pc + (size_t)cidx * OFF_C + OFF_K + h * 64; vp = pc + (size_t)cidx * OFF_C + OFF_V + h * 64; }
        float s = 0.f;
#pragma unroll
        for (int d = 0; d < 64; ++d) s += q[d] * kp[d];
        s += bias;
        const float mn = fmaxf(m, s), sc = __expf(m - mn), pr = __expf(s - mn);
        l = l * sc + pr;
#pragma unroll
        for (int d = 0; d < 64; ++d) acc[d] = acc[d] * sc + pr * vp[d];
        m = mn;
    }
    const float inv = 1.f / l;
    float* op = ycat + (size_t)t * 2048 + 1024 + h * 64;
#pragma unroll
    for (int d = 0; d < 64; ++d) op[d] = acc[d] * inv;
}

__global__ void k_conv1(const float* p1  , const float* cw  , float* g) {
    int idx = blockIdx.x * blockDim.x + threadIdx.x;
    if (idx >= SEQ * 1024) return;
    int t = idx >> 10, ch = idx & 1023;
    float a = 0.f;
    for (int k = 0; k < 3; ++k) { int tt = t + k - 1; if (tt >= 0 && tt < SEQ) { const float* r = p1 + (size_t)tt * 3072; a += cw[k * 1024 + ch] * r[1024 + ch] * r[2048 + ch]; } }
    g[idx] = p1[(size_t)t * 3072 + ch] * a;
}

inline void gemm(hipStream_t s, const float* A, int lda, const float* W, int ldw, float* C, int ldc, int M, int N, int K, int mode, const float* resid, int ldr, const float* gate) {
    dim3 grid((N + 63) / 64, M / 64);
    hipLaunchKernelGGL(k_gemm, grid, dim3(256), 0, s, A, lda, W, ldw, C, ldc, M, N, K, mode, resid, ldr, gate);
}
}

extern "C" void kernel_launch(void* const* d_in, const int* in_sizes, int n_in, void* d_out, int out_size, void* d_ws, size_t ws_size, hipStream_t stream) {
    const float* x = (const float*)d_in[0]; const float* c = (const float*)d_in[1]; const float* ctx = (const float*)d_in[2]; const float* c_ctx = (const float*)d_in[3];
    const float* mod_w = (const float*)d_in[4]; const float* mod_b = (const float*)d_in[5]; const float* norm_mix_w = (const float*)d_in[6]; const float* norm_mlp_w = (const float*)d_in[7];
    const float* mlp_w1 = (const float*)d_in[8]; const float* mlp_w2 = (const float*)d_in[9]; const float* in_w = (const float*)d_in[10]; const float* conv_w = (const float*)d_in[11];
    const float* conv_b = (const float*)d_in[12]; const float* dt_bias = (const float*)d_in[13]; const float* a_log = (const float*)d_in[14]; const float* ssd_d = (const float*)d_in[15];
    const float* ssd_norm_w = (const float*)d_in[16]; const float* rpb = (const float*)d_in[17]; const float* out_w = (const float*)d_in[18]; const float* sc_in_w = (const float*)d_in[19];
    const float* sc_conv_w = (const float*)d_in[20]; const float* sc_out_w = (const float*)d_in[21]; const float* final_w = (const float*)d_in[22];
    float* X = (float*)d_out;
    float* ws = (float*)d_ws;
    size_t off = 0;
    auto take = [&](size_t n) { float* p = ws + off; off += (n + 63) & ~(size_t)63; return p; };
    float* mod = take((size_t)2 * BATCH * 6 * D);
    float* modctx = take(2 * D);
    float* hl = take((size_t)SEQ * D);
    float* hc = take((size_t)CTX * D);
    float* pl = take((size_t)SEQ * IN0);
    float* pc = take((size_t)CTX * OFF_C);
    float* xbl = take((size_t)SEQ * CONV0);
    float* xbc = take((size_t)CTX * CONV0);
    float* y2 = take((size_t)2 * SEQ * 1024);
    float* ycat = take((size_t)SEQ * 2048);
    float* hid = take((size_t)SEQ * DFF);
    float* p1 = take((size_t)SEQ * 3072);
    float* g1 = take((size_t)SEQ * 1024);
    if (off * 4 > ws_size) { fprintf(stderr, "ws too small\n"); return; }

    const int NMOD = 2 * BATCH * 6 * D + 2 * D;
    hipLaunchKernelGGL(k_mod, dim3((NMOD + 255) / 256), dim3(256), 0, stream, c, c_ctx, mod_w, mod_b, mod, modctx);
    for (int b = 0; b < BATCH; ++b) {
        const float* xb = x + (size_t)b * SEQ * D; float* Xb = X + (size_t)b * SEQ * D;
        const float* m0 = mod + (size_t)(0 * BATCH + b) * 6 * D; const float* m1 = mod + (size_t)(1 * BATCH + b) * 6 * D;
        hipLaunchKernelGGL(k_norm, dim3(SEQ), dim3(256), 0, stream, xb, norm_mix_w, m0, m0 + D, hl);
        hipLaunchKernelGGL(k_norm, dim3(CTX), dim3(256), 0, stream, ctx + (size_t)b * CTX * D, norm_mix_w, modctx, modctx + D, hc);
        gemm(stream, hl, D, in_w, IN0, pl, IN0, SEQ, IN0, D, 0, nullptr, 0, nullptr);
        gemm(stream, hc, D, in_w, IN0, pc, OFF_C, CTX, OFF_C, D, 0, nullptr, 0, nullptr);
        hipLaunchKernelGGL(k_conv0, dim3((SEQ * 1536 + 255) / 256), dim3(256), 0, stream, pl, IN0, SEQ, 1536, conv_w, conv_b, xbl, 1);
        hipLaunchKernelGGL(k_conv0, dim3((CTX * 1280 + 255) / 256), dim3(256), 0, stream, pc, OFF_C, CTX, 1280, conv_w, conv_b, xbc, 0);
        hipLaunchKernelGGL(k_ssd, dim3(32), dim3(64), 0, stream, xbc, pc, xbl, pl, dt_bias, a_log, ssd_d, y2);
        hipLaunchKernelGGL(k_gate, dim3(SEQ), dim3(256), 0, stream, y2, pl, ssd_norm_w, ycat);
        hipLaunchKernelGGL(k_na, dim3(SEQ * 16 / 64), dim3(64), 0, stream, pl, pc, rpb, ycat);
        gemm(stream, ycat, 2048, out_w, D, Xb, D, SEQ, D, 2048, 1, xb, D, m0 + 2 * D);
        hipLaunchKernelGGL(k_norm, dim3(SEQ), dim3(256), 0, stream, Xb, norm_mlp_w, m0 + 3 * D, m0 + 4 * D, hl);
        gemm(stream, hl, D, mlp_w1, DFF, hid, DFF, SEQ, DFF, D, 2, nullptr, 0, nullptr);
        gemm(stream, hid, DFF, mlp_w2, D, Xb, D, SEQ, D, DFF, 1, Xb, D, m0 + 5 * D);
        hipLaunchKernelGGL(k_norm, dim3(SEQ), dim3(256), 0, stream, Xb, norm_mix_w + D, m1, m1 + D, hl);
        gemm(stream, hl, D, sc_in_w, 3072, p1, 3072, SEQ, 3072, D, 0, nullptr, 0, nullptr);
        hipLaunchKernelGGL(k_conv1, dim3(SEQ * 1024 / 256), dim3(256), 0, stream, p1, sc_conv_w, g1);
        gemm(stream, g1, D, sc_out_w, D, Xb, D, SEQ, D, D, 1, Xb, D, m1 + 2 * D);
        hipLaunchKernelGGL(k_norm, dim3(SEQ), dim3(256), 0, stream, Xb, norm_mlp_w + D, m1 + 3 * D, m1 + 4 * D, hl);
        gemm(stream, hl, D, mlp_w1 + (size_t)D * DFF, DFF, hid, DFF, SEQ, DFF, D, 2, nullptr, 0, nullptr);
        gemm(stream, hid, DFF, mlp_w2 + (size_t)DFF * D, D, Xb, D, SEQ, D, DFF, 1, Xb, D, m1 + 5 * D);
        hipLaunchKernelGGL(k_norm, dim3(SEQ), dim3(256), 0, stream, Xb, final_w, nullptr, nullptr, Xb);
    }
}
```

```cpp
#include <hip/hip_runtime.h>
#include <hip/hip_cooperative_groups.h>
#include <cstdio>
#include <cstdint>
namespace pg8 {
#define PG8_LAS __attribute__((address_space(3)))
typedef unsigned short bf16_t;
typedef short bf16x8 __attribute__((ext_vector_type(8)));
typedef float f32x4 __attribute__((ext_vector_type(4)));
typedef unsigned u32x4 __attribute__((ext_vector_type(4)));
constexpr int BM = 256, BK = 64, HALF = 128, HTB = HALF * BK * 2  , STAGE_BYTES = 8 * HTB, NXCD = 8, WGM = 8;

__host__ __device__ __forceinline__ int lds_byte(int r, int c) { const int st = (r >> 4) * 2 + (c >> 5), rr = r & 15, cc = c & 31, ob = rr * 64 + cc * 2; return st * 1024 + (ob ^ (((ob >> 9) & 1) << 5)); }
__host__ __device__ __forceinline__ void stage_rc(int b, int& R, int& C) { const int st = b / 1024, sb = b % 1024, swz = sb ^ (((sb >> 9) & 1) << 5); R = (st >> 1) * 16 + swz / 64; C = (st & 1) * 32 + (swz % 64) / 2; }
__host__ __device__ __forceinline__ int perm32(int rho) { const int n = rho >> 4, i = rho & 15; return 8 * (i >> 2) + 4 * n + (i & 3); }

struct Unit { int pm, pn; };
struct Gemm { const bf16_t* A; const bf16_t* Bt; int M, N, K; };

struct StaticOrder {
    int nM, nN, nwg, G, c;
    __host__ __device__ void init(int M, int N, int G_, int c_) { nM = M / BM; nN = N / BM; nwg = nM * nN; G = G_; c = c_; }
    __host__ __device__ bool next(int i, Unit& u) const {
        const long L = (long)i * G + c; if (L >= nwg) return false;
        int wgid = (int)L; { const int q = nwg / NXCD, r = nwg % NXCD, xcd = wgid % NXCD, off = wgid / NXCD; wgid = (xcd < r ? xcd * (q + 1) : r * (q + 1) + (xcd - r) * q) + off; }
        const int nig = WGM * nN, gid = wgid / nig, fm = gid * WGM, gsz = (nM - fm) < WGM ? (nM - fm) : WGM;
        u.pm = fm + ((wgid % nig) % gsz); u.pn = (wgid % nig) / gsz; return true;
    }
    __device__ __forceinline__ void a_ready(const Unit&) const {}
    __device__ __forceinline__ void done(const Unit&) const {}
};

__device__ __forceinline__ unsigned cvt_pk_bf16(float lo, float hi) { unsigned r; asm volatile("v_cvt_pk_bf16_f32 %0, %1, %2" : "=v"(r) : "v"(lo), "v"(hi)); return r; }
typedef float f32x2 __attribute__((ext_vector_type(2)));
constexpr float NA_C2 = 0.125f * 1.4426950408889634f;
__device__ __forceinline__ u32x4 pack8(f32x4 v0, f32x4 v1) { u32x4 w; w.x = cvt_pk_bf16(v0[0], v0[1]); w.y = cvt_pk_bf16(v0[2], v0[3]); w.z = cvt_pk_bf16(v1[0], v1[1]); w.w = cvt_pk_bf16(v1[2], v1[3]); return w; }

struct EpiInProj {
    static constexpr bool PERM = true, AFTER_DRAIN = false;
    bf16_t* xbc; bf16_t* zq; bf16_t* kv; float* dtraw;
    __device__ __forceinline__ void operator()(const f32x4 (&acc)[2][2][4][2], const Unit& u, int wr, int wc, int fr, int fq) const {
        const int row0 = u.pm * BM + wr * 64 + fr; const int pn = u.pn;
        if (pn == 22) {
            if (wc == 0) {
#pragma unroll
                for (int ai = 0; ai < 2; ++ai)
#pragma unroll
                    for (int m = 0; m < 4; ++m) { float* rp = dtraw + (size_t)(row0 + ai * HALF + m * 16) * 32 + 8 * fq;
                        *(f32x4*)rp = acc[ai][0][m][0]; *(f32x4*)(rp + 4) = acc[ai][0][m][1]; }
            }
            return;
        }
        bf16_t* base; int ldc, colt; float sc = 1.f;
        if (pn < 6) { base = xbc; ldc = 1536; colt = pn * 256; }
        else if (pn < 14) { base = zq; ldc = 2048; colt = (pn - 6) * 256; if (pn >= 10) sc = NA_C2; }
        else { base = kv; ldc = 2048; colt = (pn - 14) * 256; }
        const int col0 = colt + wc * 32 + 8 * fq;
#pragma unroll
        for (int ai = 0; ai < 2; ++ai)
#pragma unroll
            for (int m = 0; m < 4; ++m) { bf16_t* rowp = base + (size_t)(row0 + ai * HALF + m * 16) * ldc + col0;
#pragma unroll
                for (int bj = 0; bj < 2; ++bj) *(u32x4*)(rowp + bj * HALF) = pack8(acc[ai][bj][m][0] * sc, acc[ai][bj][m][1] * sc); }
    }
};
template <int ACT> struct EpiBf16Act {
    static constexpr bool PERM = true, AFTER_DRAIN = false;
    bf16_t* O; int ldc;
    __device__ __forceinline__ void operator()(const f32x4 (&acc)[2][2][4][2], const Unit& u, int wr, int wc, int fr, int fq) const {
        const int row0 = u.pm * BM + wr * 64 + fr, col0 = u.pn * BM + wc * 32 + 8 * fq;
#pragma unroll
        for (int ai = 0; ai < 2; ++ai)
#pragma unroll
            for (int m = 0; m < 4; ++m) { bf16_t* rowp = O + (size_t)(row0 + ai * HALF + m * 16) * ldc + col0;
#pragma unroll
                for (int bj = 0; bj < 2; ++bj) { f32x4 v0 = acc[ai][bj][m][0], v1 = acc[ai][bj][m][1];
                    if (ACT == 1) { v0 = __builtin_elementwise_max(v0, (f32x4){0.f, 0.f, 0.f, 0.f}); v1 = __builtin_elementwise_max(v1, (f32x4){0.f, 0.f, 0.f, 0.f}); v0 = v0 * v0; v1 = v1 * v1; }
                    *(u32x4*)(rowp + bj * HALF) = pack8(v0, v1); } }
    }
};
struct EpiResid {
    static constexpr bool PERM = false, AFTER_DRAIN = false;
    const float* resid; float* out; const float* gate; int gstride;
    __device__ __forceinline__ void operator()(const f32x4 (&acc)[2][2][4][2], const Unit& u, int wr, int wc, int fr, int fq) const {
        const int row0 = u.pm * BM + wr * 64 + fr, col0 = u.pn * BM + wc * 32 + 4 * fq;
        const float* gp = gate + (size_t)(u.pm >> 4) * gstride + col0;
        f32x4 gv[2][2];
#pragma unroll
        for (int bj = 0; bj < 2; ++bj)
#pragma unroll
            for (int n = 0; n < 2; ++n) gv[bj][n] = *(const f32x4*)(gp + bj * HALF + n * 16);
#pragma unroll
        for (int ai = 0; ai < 2; ++ai)
#pragma unroll
            for (int m = 0; m < 4; ++m) { const size_t off = (size_t)(row0 + ai * HALF + m * 16) * 1024 + col0;
#pragma unroll
                for (int bj = 0; bj < 2; ++bj)
#pragma unroll
                    for (int n = 0; n < 2; ++n) { const f32x4 r = *(const f32x4*)(resid + off + bj * HALF + n * 16);
                        *(f32x4*)(out + off + bj * HALF + n * 16) = r + gv[bj][n] * acc[ai][bj][m][n]; } }
    }
};
struct InProjOrder {
    int G, c;
    __device__ __forceinline__ bool next(int i, Unit& u) const {
        constexpr int nM = 128, nN = 23, nwg = nM * nN;
        const long L = (long)i * G + c;
        if (L < nwg) {
            int wgid = (int)L; { const int q = nwg / NXCD, r = nwg % NXCD, xcd = wgid % NXCD, off = wgid / NXCD; wgid = (xcd < r ? xcd * (q + 1) : r * (q + 1) + (xcd - r) * q) + off; }
            const int nig = WGM * nN, gid = wgid / nig, fm = gid * WGM, gsz = (nM - fm) < WGM ? (nM - fm) : WGM;
            u.pm = fm + ((wgid % nig) % gsz); u.pn = (wgid % nig) / gsz; return true;
        }
        const int idx = (int)(L - nwg); if (idx >= 112) return false;
        const int j = idx >> 3; u.pm = 128 + (idx & 7); u.pn = j < 5 ? j : (j < 13 ? 9 + j : 22); return true;
    }
    __device__ __forceinline__ void a_ready(const Unit&) const {}
    __device__ __forceinline__ void done(const Unit&) const {}
};
template <class Epi, class Sched, bool ALIGN_EPI = false, bool SP2 = false>
__device__ __forceinline__ void gemm_phase(PG8_LAS unsigned char* lds, const Gemm g, const Sched& S, const Epi& E) {
    const int tid = threadIdx.x, wid = __builtin_amdgcn_readfirstlane(tid >> 6), lane = tid & 63, wr = wid >> 2, wc = wid & 3, fr = lane & 15, fq = lane >> 4;
    const int K = g.K, nt = K / BK;
    unsigned voffA[2], voffB[2];
#pragma unroll
    for (int i = 0; i < 2; ++i) { int R, C; stage_rc(tid * 16 + i * 8192, R, C); const int Rb = Epi::PERM ? ((R & ~31) + perm32(R & 31)) : R;
        voffA[i] = (unsigned)(R * K + C) * 2u; voffB[i] = (unsigned)(Rb * K + C) * 2u; }
    const size_t kstep = (size_t)(BK * 2);
    const size_t hstep = (size_t)HALF * K * 2;
    const size_t tstep = 2 * hstep;
    const unsigned ldsw = (unsigned)wid * 1024u;
    const int aoff = lds_byte(wr * 64 + fr, fq * 8), boff = lds_byte(wc * 32 + fr, fq * 8);
#define PG8_SA(b, h) (((b) * 2 + (h)) * HTB)
#define PG8_SB(b, h) ((4 + (b) * 2 + (h)) * HTB)
#define PG8_STAGE(bufoff, gbase, voff) do { _Pragma("unroll") for (int _i = 0; _i < 2; ++_i) \
        __builtin_amdgcn_global_load_lds((const unsigned*)((const char*)(gbase) + (voff)[_i]), (PG8_LAS unsigned*)(lds + (bufoff) + ldsw + _i * 8192), 16, 0, 0); } while (0)
#define PG8_LDA(dst, b, h) do { _Pragma("unroll") for (int m = 0; m < 4; ++m) _Pragma("unroll") for (int k = 0; k < 2; ++k) dst[m][k] = *(const PG8_LAS bf16x8*)(lds + PG8_SA(b, h) + aoff + m * 2048 + k * 1024); } while (0)
#define PG8_LDB(dst, b, h) do { _Pragma("unroll") for (int n = 0; n < 2; ++n) _Pragma("unroll") for (int k = 0; k < 2; ++k) dst[n][k] = *(const PG8_LAS bf16x8*)(lds + PG8_SB(b, h) + boff + n * 2048 + k * 1024); } while (0)
#define PG8_MMA(ai, bj, At, Bt) do { __builtin_amdgcn_s_setprio(1); _Pragma("unroll") for (int m = 0; m < 4; ++m) _Pragma("unroll") for (int n = 0; n < 2; ++n) _Pragma("unroll") for (int k = 0; k < 2; ++k) \
        acc[ai][bj][m][n] = __builtin_amdgcn_mfma_f32_16x16x32_bf16(Bt[n][k], At[m][k], acc[ai][bj][m][n], 0, 0, 0); __builtin_amdgcn_s_setprio(0); } while (0)
#define PG8_WAIT_V(n) asm volatile("s_waitcnt vmcnt(" #n ")" ::: "memory")
#define PG8_WAIT_L(n) asm volatile("s_waitcnt lgkmcnt(" #n ")" ::: "memory")
#define PG8_BAR __builtin_amdgcn_s_barrier()
#define PG8_SCHED __builtin_amdgcn_sched_barrier(0)
    Unit cur, nxt; int ui = 0;
    if (!S.next(0, cur)) return;
    f32x4 acc[2][2][4][2];
#pragma unroll
    for (int a = 0; a < 2; ++a)
#pragma unroll
        for (int b = 0; b < 2; ++b)
#pragma unroll
            for (int m = 0; m < 4; ++m)
#pragma unroll
                for (int n = 0; n < 2; ++n) acc[a][b][m][n] = (f32x4){0.f, 0.f, 0.f, 0.f};
    bf16x8 At[4][2], B0[2][2], B1[2][2];
    const char* cA = (const char*)g.A + (size_t)cur.pm * tstep; const char* cB = (const char*)g.Bt + (size_t)cur.pn * tstep;
    S.a_ready(cur);
    if constexpr (SP2) {
        PG8_STAGE(PG8_SB(0, 0), cB, voffB); PG8_STAGE(PG8_SB(0, 1), cB + hstep, voffB); PG8_STAGE(PG8_SA(0, 0), cA, voffA); PG8_STAGE(PG8_SA(0, 1), cA + hstep, voffA);
        if (wr == 1) PG8_BAR;
        PG8_WAIT_V(2); PG8_BAR;
        PG8_STAGE(PG8_SB(1, 0), cB + kstep, voffB); PG8_STAGE(PG8_SA(1, 0), cA + kstep, voffA); PG8_STAGE(PG8_SB(1, 1), cB + hstep + kstep, voffB);
        PG8_WAIT_V(6); PG8_BAR;
    } else {
        PG8_STAGE(PG8_SB(0, 0), cB, voffB); PG8_STAGE(PG8_SA(0, 0), cA, voffA); PG8_STAGE(PG8_SB(0, 1), cB + hstep, voffB); PG8_STAGE(PG8_SA(0, 1), cA + hstep, voffA);
        if (wr == 1) PG8_BAR;
        PG8_WAIT_V(4); PG8_BAR;
        PG8_STAGE(PG8_SB(1, 0), cB + kstep, voffB); PG8_STAGE(PG8_SA(1, 0), cA + kstep, voffA); PG8_STAGE(PG8_SB(1, 1), cB + hstep + kstep, voffB);
        PG8_WAIT_V(6); PG8_BAR;
    }
    for (;;) {
        const bool has_next = S.next(ui + 1, nxt);
        const char* nA = has_next ? (const char*)g.A + (size_t)nxt.pm * tstep : cA; const char* nB = has_next ? (const char*)g.Bt + (size_t)nxt.pn * tstep : cB;
        for (int t = 0; t < nt; t += 2) {
            const bool last = (t == nt - 2);
            const char* a1 = cA + (size_t)(t + 1) * kstep;
            const char* a2 = last ? nA : cA + (size_t)(t + 2) * kstep; const char* b2 = last ? nB : cB + (size_t)(t + 2) * kstep;
            const char* a3 = a2 + kstep; const char* b3 = b2 + kstep;
            if (last && has_next) S.a_ready(nxt);
            if constexpr (SP2) {
            PG8_LDB(B0, 0, 0); PG8_LDB(B1, 0, 1); PG8_SCHED; PG8_LDA(At, 0, 0); PG8_STAGE(PG8_SA(1, 1), a1 + hstep, voffA);
            PG8_WAIT_V(8); PG8_WAIT_L(0); PG8_BAR; PG8_MMA(0, 0, At, B0); PG8_MMA(0, 1, At, B1); PG8_BAR; PG8_SCHED;
            PG8_LDA(At, 0, 1); PG8_STAGE(PG8_SB(0, 0), b2, voffB); PG8_STAGE(PG8_SB(0, 1), b2 + hstep, voffB); PG8_STAGE(PG8_SA(0, 0), a2, voffA);
            PG8_WAIT_V(8); PG8_WAIT_L(0); PG8_BAR; PG8_MMA(1, 0, At, B0); PG8_MMA(1, 1, At, B1); PG8_BAR; PG8_SCHED;
            PG8_LDB(B0, 1, 0); PG8_LDB(B1, 1, 1); PG8_SCHED; PG8_LDA(At, 1, 0); PG8_STAGE(PG8_SA(0, 1), a2 + hstep, voffA);
            PG8_WAIT_V(8); PG8_WAIT_L(0); PG8_BAR; PG8_MMA(0, 0, At, B0); PG8_MMA(0, 1, At, B1); PG8_BAR; PG8_SCHED;
            PG8_LDA(At, 1, 1); PG8_STAGE(PG8_SB(1, 0), b3, voffB); PG8_STAGE(PG8_SB(1, 1), b3 + hstep, voffB); PG8_STAGE(PG8_SA(1, 0), a3, voffA);
            PG8_WAIT_V(8); PG8_WAIT_L(0); PG8_BAR; PG8_MMA(1, 0, At, B0); PG8_MMA(1, 1, At, B1); PG8_BAR; PG8_SCHED;
            } else {
            PG8_LDB(B0, 0, 0); PG8_SCHED; PG8_LDA(At, 0, 0); PG8_STAGE(PG8_SA(1, 1), a1 + hstep, voffA);
            PG8_WAIT_L(8); PG8_BAR; PG8_WAIT_L(0); PG8_MMA(0, 0, At, B0); PG8_BAR; PG8_SCHED;
            PG8_LDB(B1, 0, 1); PG8_STAGE(PG8_SB(0, 0), b2, voffB);
            PG8_BAR; PG8_WAIT_L(0); PG8_MMA(0, 1, At, B1); PG8_BAR;
            PG8_LDA(At, 0, 1); PG8_STAGE(PG8_SA(0, 0), a2, voffA);
            PG8_BAR; PG8_WAIT_L(0); PG8_MMA(1, 0, At, B0); PG8_BAR; PG8_SCHED;
            PG8_STAGE(PG8_SB(0, 1), b2 + hstep, voffB);
            PG8_WAIT_V(6); PG8_BAR; PG8_MMA(1, 1, At, B1); PG8_BAR;
            PG8_LDB(B0, 1, 0); PG8_SCHED; PG8_LDA(At, 1, 0); PG8_STAGE(PG8_SA(0, 1), a2 + hstep, voffA);
            PG8_WAIT_L(8); PG8_BAR; PG8_WAIT_L(0); PG8_MMA(0, 0, At, B0); PG8_BAR; PG8_SCHED;
            PG8_LDB(B1, 1, 1); PG8_STAGE(PG8_SB(1, 0), b3, voffB);
            PG8_BAR; PG8_WAIT_L(0); PG8_MMA(0, 1, At, B1); PG8_BAR;
            PG8_LDA(At, 1, 1); PG8_STAGE(PG8_SA(1, 0), a3, voffA);
            PG8_BAR; PG8_WAIT_L(0); PG8_MMA(1, 0, At, B0); PG8_BAR; PG8_SCHED;
            PG8_STAGE(PG8_SB(1, 1), b3 + hstep, voffB);
            PG8_WAIT_V(6); PG8_BAR; PG8_MMA(1, 1, At, B1); PG8_BAR;
            }
        }
        if constexpr (ALIGN_EPI) { if (wr == 0) PG8_BAR; }
        if constexpr (!Epi::AFTER_DRAIN) { E(acc, cur, wr, wc, fr, fq); S.done(cur); }
        if (!has_next) break;
#pragma unroll
        for (int a = 0; a < 2; ++a)
#pragma unroll
            for (int b = 0; b < 2; ++b)
#pragma unroll
                for (int m = 0; m < 4; ++m)
#pragma unroll
                    for (int n = 0; n < 2; ++n) acc[a][b][m][n] = (f32x4){0.f, 0.f, 0.f, 0.f};
        cur = nxt; cA = nA; cB = nB; ++ui;
        if constexpr (ALIGN_EPI) { if (wr == 1) PG8_BAR; }
    }
    PG8_WAIT_V(0);
    if constexpr (!ALIGN_EPI) { if (wr == 0) PG8_BAR; }
    PG8_BAR;
    if constexpr (Epi::AFTER_DRAIN) { E.fused(acc, cur, wr, wc, fr, fq, lds, wid, lane); S.done(cur); }
#undef PG8_SA
#undef PG8_SB
#undef PG8_STAGE
#undef PG8_LDA
#undef PG8_LDB
#undef PG8_MMA
#undef PG8_WAIT_V
#undef PG8_WAIT_L
#undef PG8_BAR
#undef PG8_SCHED
}
}
#define GAS __attribute__((address_space(1)))
#define LAS __attribute__((address_space(3)))
typedef unsigned short bf16;
typedef unsigned v4u __attribute__((ext_vector_type(4)));
typedef float f32x4 __attribute__((ext_vector_type(4)));
typedef short bf16x8 __attribute__((ext_vector_type(8)));
typedef GAS unsigned gu32;
typedef GAS unsigned long long gu64;
#define RLX_AGENT __ATOMIC_RELAXED, __HIP_MEMORY_SCOPE_AGENT
#define LDS_WAIT() asm volatile("s_waitcnt lgkmcnt(0)" ::: "memory")
#define VM_WAIT() asm volatile("s_waitcnt vmcnt(0)" ::: "memory")
__device__ __forceinline__ unsigned long long rt() { return __builtin_amdgcn_s_memrealtime(); }
__device__ __forceinline__ unsigned f2bf(float f) { unsigned u = __builtin_bit_cast(unsigned, f); return (u + 0x7fffu + ((u >> 16) & 1u)) >> 16; }
__device__ __forceinline__ unsigned pk2(float lo, float hi) { return f2bf(lo) | (f2bf(hi) << 16); }

__device__ __forceinline__ float wave_sum(float v) {
#pragma unroll
    for (int o = 1; o < 64; o <<= 1) v += __shfl_xor(v, o);
    return v;
}
#define XB_TMO      128
#define XB_XCNT(j)  (256  + 64 * (j))
#define XB_XSUB(j)  (1280 + 64 * (j))
#define XB_XGEN(j)  (2304 + 64 * (j))
#define XB_TOP      3328
#define XB_TOPGEN   3392
#define XCD_BAR_WORDS 3456
#define XB_SPIN_CAP (1u << 18)

__device__ __forceinline__ unsigned xb_ld(unsigned* p)              { return __hip_atomic_load(p, __ATOMIC_RELAXED, __HIP_MEMORY_SCOPE_AGENT); }
__device__ __forceinline__ unsigned xb_add(unsigned* p, unsigned v) { return __hip_atomic_fetch_add(p, v, __ATOMIC_RELAXED, __HIP_MEMORY_SCOPE_AGENT); }
__device__ __forceinline__ unsigned xb_xcc_id() { return (unsigned)__builtin_amdgcn_s_getreg((3 << 11) | 20) & 0xFu; }
#define XB_SPIN(cond, bar) do { unsigned _sp = 0; while (cond) { __builtin_amdgcn_s_sleep(1); \
    if ((++_sp & 255u) == 0u) { if (xb_ld(&(bar)[XB_TMO])) break; if (_sp > XB_SPIN_CAP) { atomicAdd(&(bar)[XB_TMO], 1u); break; } } } } while (0)

struct XcdBarrier {
    unsigned* bar; unsigned x;
    volatile LAS unsigned* st;
};

__device__ __forceinline__ XcdBarrier xcd_barrier_post(unsigned* bar, volatile LAS unsigned* st) {
    XcdBarrier b; b.bar = bar; b.x = xb_xcc_id(); b.st = st;
    if (threadIdx.x == 0) (void)xb_add(&bar[XB_XCNT(b.x)], 1u);
    return b;
}
__device__ __forceinline__ void xcd_barrier_complete(unsigned* bar, unsigned x, unsigned& nloc, unsigned& nx) {
    const unsigned G = gridDim.x * gridDim.y * gridDim.z;
    unsigned sum, cnt, mine, sp = 0u;
    for (;;) {
        sum = 0u; cnt = 0u; mine = 0u;
#pragma unroll
        for (unsigned j = 0; j < 16; ++j) { const unsigned c = xb_ld(&bar[XB_XCNT(j)]); sum += c; cnt += (c > 0u) ? 1u : 0u; mine = (j == x) ? c : mine; }
        if (sum == G) break;
        __builtin_amdgcn_s_sleep(1);
        if ((++sp & 255u) == 0u) { if (xb_ld(&bar[XB_TMO])) break; if (sp > XB_SPIN_CAP) { atomicAdd(&bar[XB_TMO], 1u); break; } }
    }
    nloc = mine > 0u ? mine : 1u; nx = cnt > 0u ? cnt : 1u;
}

__device__ __forceinline__ void xcd_barrier(const XcdBarrier& b) {
    asm volatile("s_waitcnt vmcnt(0)" ::: "memory");
    __syncthreads();
    if (threadIdx.x == 0) {
        unsigned* bar = b.bar;
        __builtin_amdgcn_s_waitcnt(0);
        unsigned nloc = b.st[0], nx = b.st[1];
        if (nloc == 0u) { xcd_barrier_complete(bar, b.x, nloc, nx); b.st[0] = nloc; b.st[1] = nx; }
        const unsigned old = xb_add(&bar[XB_XSUB(b.x)], 1u);
        const unsigned gen = old / nloc;
        if (old + 1u == (gen + 1u) * nloc) {
            __builtin_amdgcn_fence(__ATOMIC_RELEASE, "agent");
            asm volatile("s_waitcnt vmcnt(0)" ::: "memory");
            const unsigned og = xb_add(&bar[XB_TOP], 1u);
            const unsigned tg = og / nx;
            if (og + 1u == (tg + 1u) * nx) xb_add(&bar[XB_TOPGEN], 1u);
            else XB_SPIN(xb_ld(&bar[XB_TOPGEN]) == tg, bar);
            __builtin_amdgcn_fence(__ATOMIC_ACQUIRE, "agent");
            xb_add(&bar[XB_XGEN(b.x)], 1u);
            asm volatile("s_waitcnt vmcnt(0)" ::: "memory");
        } else {
            XB_SPIN(xb_ld(&bar[XB_XGEN(b.x)]) == gen, bar);
            __builtin_amdgcn_fence(__ATOMIC_ACQUIRE, "agent");
            asm volatile("s_waitcnt vmcnt(0)" ::: "memory");
        }
    }
    __syncthreads();
}
namespace cg = cooperative_groups;
constexpr int NWAVES = 8, NTHR = 512;
constexpr int D = 1024, BATCH = 8, SEQ = 4096, CTXL = 256, M_LAT = BATCH * SEQ, M_CTX = BATCH * CTXL, M_ALL = M_LAT + M_CTX;
constexpr int DFF = 4096, NIN0 = 5888;
constexpr int OFF_X = 0, OFF_B = 1024, OFF_DT = 1280, OFF_K = 1312, OFF_V = 2336, OFF_C = 3360, OFF_Z = 3616, OFF_Q = 4640, IN0 = 5664;
constexpr int NCH = 34;
constexpr float RMS_EPS = 1e-6f, LOG2E = 1.4426950408889634f;
constexpr size_t MiB = 1u << 20;
constexpr size_t WS_CTL = 0, CTL_ZERO_BYTES = 64 * 1024;
constexpr size_t WS_MOD = 1 * MiB, WS_MODCTX = 1 * MiB + 512 * 1024;
constexpr size_t WS_WIN = 2 * MiB, WS_WOUT = 14 * MiB;
constexpr size_t WS_H = 18 * MiB;
constexpr size_t WS_XBC = 86 * MiB;
constexpr size_t WS_ZQ = 188 * MiB;
constexpr size_t WS_KV = 316 * MiB;
constexpr size_t WS_DTRAW = 452 * MiB;
constexpr size_t WS_BC = 457 * MiB, WS_CC = 474 * MiB;
constexpr size_t WS_LA = 490 * MiB, WS_LD = 495 * MiB, WS_ATOT = 500 * MiB;
constexpr size_t WS_END = 501 * MiB;
constexpr size_t WS_W1T0 = 86 * MiB, WS_W2T0 = 94 * MiB, WS_W1T1 = 102 * MiB, WS_W2T1 = 110 * MiB, WS_SCIN = 118 * MiB, WS_SCOUT = 124 * MiB;
constexpr size_t WS_YF = 316 * MiB, WS_YB = 380 * MiB;
constexpr size_t WS_HID = 188 * MiB;
constexpr size_t WS_P1 = 188 * MiB, WS_G1 = 380 * MiB;
constexpr int RING_BYTES = 131072, LDSCTL_OFF = RING_BYTES, MISC_OFF = LDSCTL_OFF + 320, LDS_BYTES = 147456;

typedef short s16x4 __attribute__((ext_vector_type(4)));
typedef float f32x16 __attribute__((ext_vector_type(16)));
typedef float f32x2 __attribute__((ext_vector_type(2)));
typedef __bf16 bf16x2_t __attribute__((ext_vector_type(2)));
typedef LAS unsigned char* lptr;
__device__ __forceinline__ unsigned cvtpk(float lo, float hi) { f32x2 v = {lo, hi}; bf16x2_t b = __builtin_convertvector(v, bf16x2_t); return __builtin_bit_cast(unsigned, b); }
__device__ __forceinline__ float bflo(unsigned u) { return __uint_as_float(u << 16); }
__device__ __forceinline__ float bfhi(unsigned u) { return __uint_as_float(u & 0xffff0000u); }
__device__ __forceinline__ float silu_f(float v) { return v / (1.f + __expf(-v)); }
__device__ __forceinline__ float softplus_f(float v) { return fmaxf(v, 0.f) + log1pf(__expf(-fabsf(v))); }
__device__ __forceinline__ int crow(int r, int hi) { return (r & 3) + 8 * (r >> 2) + 4 * hi; }
__device__ __forceinline__ int clampi(int v, int lo, int hi) { return v < lo ? lo : (v > hi ? hi : v); }
__device__ __forceinline__ s16x4 trd(lptr p) { typedef short v4i16_t __attribute__((ext_vector_type(4))); return __builtin_bit_cast(s16x4, __builtin_amdgcn_ds_read_tr16_b64_v4i16((LAS v4i16_t*)p)); }
__device__ __forceinline__ bf16x8 cat8(s16x4 a, s16x4 b) { return (bf16x8){a[0], a[1], a[2], a[3], b[0], b[1], b[2], b[3]}; }
#define MFMA32(a, b, c) __builtin_amdgcn_mfma_f32_32x32x16_bf16((a), (b), (c), 0, 0, 0)
__device__ __forceinline__ unsigned off_b(unsigned row, unsigned ch) { return 256u * row + 16u * (ch ^ (((row & 3) << 2) | ((row >> 2) & 3))); }

struct Args {
    const float* in[23]; float* out; unsigned char* ws; int ph_lo, ph_hi, use_cg, pad;
};

__device__ __forceinline__ void transpose_block(const float* W, int ldw, int K, bf16* WT, int dst_row0, int src_col0, int kb, LAS float* scr, int lane) {
    const int k0 = 64 * kb;
#pragma unroll 8
    for (int i = 0; i < 32; ++i) { const int kk = 2 * i + (lane >> 5); scr[kk * 33 + (lane & 31)] = W[(size_t)(k0 + kk) * ldw + src_col0 + (lane & 31)]; }
    LDS_WAIT(); asm volatile("" ::: "memory");
    const int c = lane & 7;
#pragma unroll
    for (int j = 0; j < 4; ++j) { const int n = (lane >> 3) + 8 * j; const LAS float* s = scr + (8 * c) * 33 + n;
        v4u o; o.x = cvtpk(s[0 * 33], s[1 * 33]); o.y = cvtpk(s[2 * 33], s[3 * 33]); o.z = cvtpk(s[4 * 33], s[5 * 33]); o.w = cvtpk(s[6 * 33], s[7 * 33]);
        *(GAS v4u*)(WT + (size_t)(dst_row0 + n) * K + k0 + 8 * c) = o; }
    LDS_WAIT(); asm volatile("" ::: "memory");
}
__device__ __forceinline__ void transpose_plain(const float* W, int K, int N, bf16* WT, int item, LAS float* scr, int lane) {
    const int nblk = N / 32, kb = item / nblk, nb = item % nblk;
    transpose_block(W, N, K, WT, 32 * nb, 32 * nb, kb, scr, lane);
}
__device__ __forceinline__ int in0_src_col(int dst) {
    if (dst < 1024) return OFF_X + dst;
    if (dst < 1280) return OFF_B + dst - 1024;
    if (dst < 1536) return OFF_C + dst - 1280;
    if (dst < 2560) return OFF_Z + dst - 1536;
    if (dst < 3584) return OFF_Q + dst - 2560;
    if (dst < 4608) return OFF_K + dst - 3584;
    if (dst < 5632) return OFF_V + dst - 4608;
    return OFF_DT + dst - 5632;
}
__device__ __forceinline__ void p0_prologue(const Args& A, lptr lds, int tid, int vcu, int G) {
    const int lane = tid & 63, wave = tid >> 6;
    unsigned char* ws = A.ws;
    if (blockIdx.x < 192) {
        const int task = blockIdx.x, layer = task / 96, n0 = (task % 96) * 64;
        LAS float* sc = (LAS float*)lds;
        LAS float* red = (LAS float*)(lds + 9 * 4096);
        for (int i = tid; i < 9 * 1024; i += NTHR) { const float v = i < 8192 ? A.in[1][i] : A.in[3][i - 8192]; sc[i] = silu_f(v); }
        __syncthreads();
        const int col = tid & 63, kp = tid >> 6;
        float acc[9];
#pragma unroll
        for (int bb = 0; bb < 9; ++bb) acc[bb] = 0.f;
        const float* wp = A.in[4] + (size_t)layer * D * 6 * D + n0 + col;
        for (int k = kp * 128; k < kp * 128 + 128; ++k) { const float wv = wp[(size_t)k * 6 * D];
#pragma unroll
            for (int bb = 0; bb < 9; ++bb) acc[bb] += sc[bb * 1024 + k] * wv; }
#pragma unroll
        for (int bb = 0; bb < 9; ++bb) red[(kp * 9 + bb) * 64 + col] = acc[bb];
        __syncthreads();
        float* MOD = (float*)(ws + WS_MOD); float* MODCTX = (float*)(ws + WS_MODCTX);
        for (int i = tid; i < 9 * 64; i += NTHR) { const int bb = i >> 6, cc = i & 63; float s = A.in[5][layer * 6 * D + n0 + cc];
#pragma unroll
            for (int q = 0; q < 8; ++q) s += red[(q * 9 + bb) * 64 + cc];
            if (bb < 8) MOD[(size_t)(layer * 8 + bb) * 6 * D + n0 + cc] = s; else if (layer == 0 && n0 + cc < 2 * D) MODCTX[n0 + cc] = s; }
        __syncthreads();
    }
    LAS float* scr = (LAS float*)(lds + wave * 16384);
    const int gw = vcu * NWAVES + wave, NGW = G * NWAVES;
    bf16* WIN = (bf16*)(ws + WS_WIN); bf16* WOUT = (bf16*)(ws + WS_WOUT);
    constexpr int I_IN = (IN0 / 32) * (D / 64), I_OUT = (D / 32) * (2 * D / 64);
    for (int it = gw; it < I_IN + I_OUT; it += NGW) {
        if (it < I_IN) { const int nb = it % (IN0 / 32), kb = it / (IN0 / 32); transpose_block(A.in[10], IN0, D, WIN, 32 * nb, in0_src_col(32 * nb), kb, scr, lane); }
        else transpose_plain(A.in[18], 2 * D, D, WOUT, it - I_IN, scr, lane);
    }
    { const int gt = vcu * NTHR + tid, NGT = G * NTHR; v4u z = {0u, 0u, 0u, 0u};
      for (int i = gt; i < 224 * 128; i += NGT) *(GAS v4u*)((unsigned char*)WIN + (size_t)IN0 * 2048 + (size_t)i * 16) = z; }
}
__device__ __forceinline__ void late_weights(const Args& A, lptr lds, int tid, int vcu, int G) {
    const int lane = tid & 63, wave = tid >> 6; unsigned char* ws = A.ws;
    LAS float* scr = (LAS float*)(lds + wave * 16384);
    const int gw = vcu * NWAVES + wave, NGW = G * NWAVES;
    constexpr int I_1 = (DFF / 32) * (D / 64), I_2 = (D / 32) * (DFF / 64), I_SI = (3 * D / 32) * (D / 64), I_SO = (D / 32) * (D / 64);
    constexpr int TOT = 2 * I_1 + 2 * I_2 + I_SI + I_SO;
    for (int it = gw; it < TOT; it += NGW) {
        int r = it;
        if (r < I_1) { transpose_plain(A.in[8], D, DFF, (bf16*)(ws + WS_W1T0), r, scr, lane); continue; } r -= I_1;
        if (r < I_1) { transpose_plain(A.in[8] + (size_t)D * DFF, D, DFF, (bf16*)(ws + WS_W1T1), r, scr, lane); continue; } r -= I_1;
        if (r < I_2) { transpose_plain(A.in[9], DFF, D, (bf16*)(ws + WS_W2T0), r, scr, lane); continue; } r -= I_2;
        if (r < I_2) { transpose_plain(A.in[9] + (size_t)DFF * D, DFF, D, (bf16*)(ws + WS_W2T1), r, scr, lane); continue; } r -= I_2;
        if (r < I_SI) { transpose_plain(A.in[19], D, 3 * D, (bf16*)(ws + WS_SCIN), r, scr, lane); continue; } r -= I_SI;
        transpose_plain(A.in[21], D, D, (bf16*)(ws + WS_SCOUT), r, scr, lane);
    }
}
__device__ __forceinline__ void norm_row_bf16(const float* xrow, const float* w, const float* shift, const float* scale, bf16* orow, int lane) {
    const GAS f32x4* xr = (const GAS f32x4*)xrow + lane;
    f32x4 v[4]; float s = 0.f;
#pragma unroll
    for (int j = 0; j < 4; ++j) { v[j] = xr[64 * j]; s += (v[j].x * v[j].x + v[j].y * v[j].y) + (v[j].z * v[j].z + v[j].w * v[j].w); }
    const float rstd = rsqrtf(wave_sum(s) * (1.f / D) + RMS_EPS);
    GAS unsigned long long* o8 = (GAS unsigned long long*)orow + lane;
#pragma unroll
    for (int j = 0; j < 4; ++j) { const int c = 4 * lane + 256 * j;
        const f32x4 wv = *(const f32x4*)(w + c), sh = *(const f32x4*)(shift + c), sc = *(const f32x4*)(scale + c);
        const f32x4 h = v[j] * rstd * wv * (sc + 1.f) + sh;
        o8[64 * j] = (unsigned long long)cvtpk(h.x, h.y) | ((unsigned long long)cvtpk(h.z, h.w) << 32); }
}
__device__ __forceinline__ void norm_phase(const Args& A, const float* src, const float* w, int layer, int sel  , bool with_ctx, int tid, int vcu, int G) {
    const int lane = tid & 63, wave = tid >> 6, gw = vcu * NWAVES + wave, NGW = G * NWAVES;
    const float* MOD = (const float*)(A.ws + WS_MOD); const float* MODCTX = (const float*)(A.ws + WS_MODCTX);
    bf16* H = (bf16*)(A.ws + WS_H);
    const int nrows = with_ctx ? M_ALL : M_LAT;
    for (int r = gw; r < nrows; r += NGW) {
        if (r < M_LAT) { const float* mb = MOD + (size_t)(layer * 8 + (r >> 12)) * 6 * D + (sel ? 3 * D : 0);
            norm_row_bf16(src + (size_t)r * D, w, mb, mb + D, H + (size_t)r * D, lane); }
        else norm_row_bf16(A.in[2] + (size_t)(r - M_LAT) * D, w, MODCTX, MODCTX + D, H + (size_t)r * D, lane);
    }
}
__device__ __forceinline__ void final_norm_phase(const Args& A, int tid, int vcu, int G) {
    const int lane = tid & 63, wave = tid >> 6, gw = vcu * NWAVES + wave, NGW = G * NWAVES;
    const float* w = A.in[22];
    for (int r = gw; r < M_LAT; r += NGW) {
        GAS f32x4* xr = (GAS f32x4*)(A.out + (size_t)r * D) + lane;
        f32x4 v[4]; float s = 0.f;
#pragma unroll
        for (int j = 0; j < 4; ++j) { v[j] = xr[64 * j]; s += (v[j].x * v[j].x + v[j].y * v[j].y) + (v[j].z * v[j].z + v[j].w * v[j].w); }
        const float rstd = rsqrtf(wave_sum(s) * (1.f / D) + RMS_EPS);
#pragma unroll
        for (int j = 0; j < 4; ++j) xr[64 * j] = v[j] * rstd * *(const f32x4*)(w + 4 * lane + 256 * j);
    }
}
constexpr int NA_K0 = 0, NA_V0 = 16384, NA_TBL = 32768, NA_WSF = 36864;
__device__ __forceinline__ void na_unit(const Args& A, lptr lds, int b, int h, int band, int tid) {
    const int lane = tid & 63, w = __builtin_amdgcn_readfirstlane(tid >> 6), r32 = lane & 31, hi = lane >> 5;
    const bf16* KV = (const bf16*)(A.ws + WS_KV); bf16* ZQ = (bf16*)(A.ws + WS_ZQ);
    const int qr = 4 * band + (w >> 1), qc = 32 * (w & 1) + r32;
    const size_t tq = (size_t)b * SEQ + qr * 64 + qc;
    bf16* qp = ZQ + tq * 2048 + 1024 + h * 64;
    bf16x8 qf[4];
#pragma unroll
    for (int s = 0; s < 4; ++s) qf[s] = *(const bf16x8*)(qp + 16 * s + 8 * hi);
    LAS float* tbl = (LAS float*)(lds + NA_TBL);
    LAS float* wsf = (LAS float*)(lds + NA_WSF) + w * 64;
    for (int i = tid; i < 640; i += NTHR) tbl[i] = (i >= 64 && i < 64 + 465) ? A.in[17][h * 465 + i - 64] * LOG2E : 0.f;
    const int rlo = clampi(4 * band - 4, 0, 56), rhi = clampi(4 * band - 1, 0, 56) + 7, nt = 4 + (rhi - rlo + 1);
    const int rs = clampi(qr - 4, 0, 56), wsc = clampi(qc - 8, 0, 48);
    const int skey = tid >> 3, sch = tid & 7;
    const unsigned kwoff = skey * 128 + ((sch ^ ((skey >> 1) & 7)) << 4);
    const unsigned vwoff = skey * 128 + ((sch ^ (((skey >> 1) & 1) << 2)) << 4);
    v4u kreg, vreg;
#define NA_LOAD(t) do { const size_t kr_ = (t) < 4 ? (size_t)M_LAT + b * CTXL + 64 * (t) + skey : (size_t)b * SEQ + (rlo + (t) - 4) * 64 + skey; \
        const bf16* p_ = KV + kr_ * 2048 + h * 64 + sch * 8; kreg = *(const GAS v4u*)p_; vreg = *(const GAS v4u*)(p_ + 1024); } while (0)
#define NA_STORE(buf) do { *(LAS v4u*)(lds + NA_K0 + (buf) * 8192 + kwoff) = kreg; *(LAS v4u*)(lds + NA_V0 + (buf) * 8192 + vwoff) = vreg; } while (0)
    NA_LOAD(0); NA_STORE(0);
    __syncthreads();
    float m_run = -1e30f, l_run = 0.f;
    f32x16 o0, o1;
#pragma unroll
    for (int r = 0; r < 16; ++r) { o0[r] = 0.f; o1[r] = 0.f; }
    const unsigned kro = r32 * 128, ksw = (r32 >> 1) & 7;
    const int q4 = (lane & 15) >> 2, p4 = lane & 3, blk = (lane >> 4) & 1;
    for (int t = 0; t < nt; ++t) {
        const int buf = t & 1;
        if (t + 1 < nt) NA_LOAD(t + 1);
        const int kr = rlo + t - 4;
        const bool part = (t < 4) || (kr >= rs && kr < rs + 8);
        if (part) {
            lptr kb = lds + NA_K0 + buf * 8192, vb = lds + NA_V0 + buf * 8192;
            f32x16 p0, p1;
#pragma unroll
            for (int r = 0; r < 16; ++r) { p0[r] = 0.f; p1[r] = 0.f; }
#pragma unroll
            for (int s = 0; s < 4; ++s) {
                const unsigned co = ((unsigned)((2 * s + hi) ^ ksw)) << 4;
                const bf16x8 a0 = *(const LAS bf16x8*)(kb + kro + co);
                const bf16x8 a1 = *(const LAS bf16x8*)(kb + 4096 + kro + co);
                p0 = MFMA32(a0, qf[s], p0); p1 = MFMA32(a1, qf[s], p1);
            }
            if (t >= 4) {
                const int dr = kr - qr + 7;
                const LAS float* tb = tbl + 64 + dr * 31 + 15 - qc + 4 * hi;
                const int lo = wsc - 4 * hi;
#pragma unroll
                for (int r = 0; r < 16; ++r) { const int kcc = (r & 3) + 8 * (r >> 2);
                    p0[r] = ((unsigned)(kcc - lo) < 16u) ? p0[r] + tb[kcc] : -1e30f;
                    p1[r] = ((unsigned)(kcc + 32 - lo) < 16u) ? p1[r] + tb[kcc + 32] : -1e30f; }
            }
            float mt = fmaxf(p0[0], p1[0]);
#pragma unroll
            for (int r = 1; r < 16; ++r) mt = fmaxf(mt, fmaxf(p0[r], p1[r]));
            mt = fmaxf(mt, __shfl_xor(mt, 32));
            const float m_new = fmaxf(m_run, mt), alpha = __builtin_amdgcn_exp2f(m_run - m_new);
            m_run = m_new;
            float rsum = 0.f;
#pragma unroll
            for (int r = 0; r < 16; ++r) { p0[r] = __builtin_amdgcn_exp2f(p0[r] - m_new); p1[r] = __builtin_amdgcn_exp2f(p1[r] - m_new); rsum += p0[r] + p1[r]; }
            l_run = l_run * alpha + rsum;
            if (hi == 0) wsf[r32] = alpha;
#pragma unroll
            for (int r = 0; r < 16; ++r) { const float a = wsf[crow(r, hi)]; o0[r] *= a; o1[r] *= a; }
            bf16x8 pa[4];
#pragma unroll
            for (int k = 0; k < 4; ++k) { v4u u;
#pragma unroll
                for (int j = 0; j < 4; ++j) { const int rr = 8 * (k & 1) + 2 * j; u[j] = (k < 2) ? cvtpk(p0[rr], p0[rr + 1]) : cvtpk(p1[rr], p1[rr + 1]); }
                pa[k] = __builtin_bit_cast(bf16x8, u); }
#pragma unroll
            for (int c = 0; c < 2; ++c)
#pragma unroll
                for (int k = 0; k < 4; ++k) {
                    const unsigned ch = 4 * c + 2 * blk + (p4 >> 1);
                    const unsigned ra = 16 * k + 4 * hi + q4, rb = ra + 8;
                    const s16x4 lo4 = trd(vb + ra * 128 + ((ch ^ (((ra >> 1) & 1) << 2)) << 4) + 8 * (p4 & 1));
                    const s16x4 hi4 = trd(vb + rb * 128 + ((ch ^ (((rb >> 1) & 1) << 2)) << 4) + 8 * (p4 & 1));
                    const bf16x8 vf = cat8(lo4, hi4);
                    if (c == 0) o0 = MFMA32(pa[k], vf, o0); else o1 = MFMA32(pa[k], vf, o1);
                }
        }
        if (t + 1 < nt) NA_STORE(buf ^ 1);
        __syncthreads();
    }
    const float lt = l_run + __shfl_xor(l_run, 32);
    if (hi == 0) wsf[r32] = 1.f / lt;
    bf16* ob = ZQ + ((size_t)b * SEQ + qr * 64 + 32 * (w & 1)) * 2048 + 1024 + h * 64 + r32;
#pragma unroll
    for (int r = 0; r < 16; ++r) { const int q = crow(r, hi); const float inv = wsf[q];
        ob[(size_t)q * 2048] = (bf16)(cvtpk(o0[r] * inv, 0.f) & 0xffffu);
        ob[(size_t)q * 2048 + 32] = (bf16)(cvtpk(o1[r] * inv, 0.f) & 0xffffu); }
    __syncthreads();
#undef NA_LOAD
#undef NA_STORE
}

constexpr int PR_SLAB = 0, PR_DTS = 16384, PR_LAS = 16384 + 32 * 129 * 4, PR_LDS = PR_LAS + 32 * 129 * 4;
__device__ __forceinline__ void prep_unit(const Args& A, lptr lds, int ca, int tid) {
    const int b = ca / NCH, cid_all = ca % NCH; const bool is_ctx = cid_all < 2; const int cid = is_ctx ? cid_all : cid_all - 2;
    const int L = is_ctx ? CTXL : SEQ, t0 = 128 * cid; const size_t rowbase = is_ctx ? (size_t)M_LAT + b * CTXL : (size_t)b * SEQ;
    const bf16* XBC = (const bf16*)(A.ws + WS_XBC); bf16* XT = (bf16*)(A.ws + WS_H); bf16* BC = (bf16*)(A.ws + WS_BC); bf16* CC = (bf16*)(A.ws + WS_CC);
    const float* cw = A.in[11]; const float* cb = A.in[12];
    {
        const int t = tid >> 2, pg = tid & 3;
        LAS unsigned char* slab = lds + PR_SLAB;
        for (int hh = 0; hh < 16; ++hh) {
            const int c0 = hh * 64 + pg * 16;
            float acc[16];
#pragma unroll
            for (int e = 0; e < 16; ++e) acc[e] = cb[c0 + e];
#pragma unroll
            for (int k = 0; k < 3; ++k) { const int tt = t0 + t + k - 1;
                if (tt >= 0 && tt < L) { const bf16* src = XBC + (rowbase + tt) * 1536 + c0; const v4u u0 = *(const GAS v4u*)src, u1 = *(const GAS v4u*)(src + 8);
                    const float* wk = cw + k * 1536 + c0;
#pragma unroll
                    for (int e = 0; e < 4; ++e) { acc[2 * e] += wk[2 * e] * bflo(u0[e]); acc[2 * e + 1] += wk[2 * e + 1] * bfhi(u0[e]);
                        acc[8 + 2 * e] += wk[8 + 2 * e] * bflo(u1[e]); acc[8 + 2 * e + 1] += wk[8 + 2 * e + 1] * bfhi(u1[e]); } } }
            v4u o0, o1;
#pragma unroll
            for (int e = 0; e < 4; ++e) { o0[e] = cvtpk(silu_f(acc[2 * e]), silu_f(acc[2 * e + 1])); o1[e] = cvtpk(silu_f(acc[8 + 2 * e]), silu_f(acc[8 + 2 * e + 1])); }
            *(LAS v4u*)(slab + t * 128 + pg * 32) = o0; *(LAS v4u*)(slab + t * 128 + pg * 32 + 16) = o1;
            __syncthreads();
#pragma unroll
            for (int i2 = 0; i2 < 2; ++i2) { const int item = tid + NTHR * i2, p = item >> 4, ug = item & 15, s = ug >> 1, hh2 = ug & 1;
                unsigned short v[8];
#pragma unroll
                for (int jj = 0; jj < 8; ++jj) { const int tt = 16 * s + 8 * (jj >> 2) + 4 * hh2 + (jj & 3); v[jj] = *(const LAS unsigned short*)(slab + tt * 128 + p * 2); }
                v4u o; o.x = v[0] | ((unsigned)v[1] << 16); o.y = v[2] | ((unsigned)v[3] << 16); o.z = v[4] | ((unsigned)v[5] << 16); o.w = v[6] | ((unsigned)v[7] << 16);
                *(GAS v4u*)(XT + (((size_t)ca * 16 + hh) * 64 + p) * 128 + ug * 8) = o; }
            __syncthreads();
        }
    }
    {
        const int ngrp = is_ctx ? 32 : 64;
        for (int item = tid; item < 128 * ngrp; item += NTHR) {
            const int t = item / ngrp, gq = item % ngrp, c0 = 1024 + gq * 8;
            float acc[8];
#pragma unroll
            for (int e = 0; e < 8; ++e) acc[e] = cb[c0 + e];
#pragma unroll
            for (int k = 0; k < 3; ++k) { const int tt = t0 + t + k - 1;
                if (tt >= 0 && tt < L) { const v4u u0 = *(const GAS v4u*)(XBC + (rowbase + tt) * 1536 + c0); const float* wk = cw + k * 1536 + c0;
#pragma unroll
                    for (int e = 0; e < 4; ++e) { acc[2 * e] += wk[2 * e] * bflo(u0[e]); acc[2 * e + 1] += wk[2 * e + 1] * bfhi(u0[e]); } } }
            v4u o;
#pragma unroll
            for (int e = 0; e < 4; ++e) o[e] = cvtpk(silu_f(acc[2 * e]), silu_f(acc[2 * e + 1]));
            if (gq < 32) *(GAS v4u*)(BC + (rowbase + t0 + t) * 256 + gq * 8) = o;
            else *(GAS v4u*)(CC + (rowbase + t0 + t) * 256 + (gq - 32) * 8) = o;
        }
    }
    {
        LAS float* dts = (LAS float*)(lds + PR_DTS); LAS float* las = (LAS float*)(lds + PR_LAS); LAS float* ldl = (LAS float*)(lds + PR_LDS);
        const float* DTRAW = (const float*)(A.ws + WS_DTRAW);
        for (int i = tid; i < 4096; i += NTHR) { const int t = i >> 5, j = i & 31; dts[j * 129 + t] = softplus_f(DTRAW[(rowbase + t0 + t) * 32 + j] + A.in[13][j]); }
        __syncthreads();
        if (tid < 32) { const int j = tid; const float Aj = -__expf(A.in[14][j]) * LOG2E; float acc = 0.f;
            if (j < 16) { for (int t = 0; t < 128; ++t) { const float dt = dts[j * 129 + t]; acc += dt * Aj; las[j * 129 + t] = acc; ldl[j * 129 + t] = __log2f(dt); } }
            else { for (int t = 127; t >= 0; --t) { const float dt = dts[j * 129 + t]; acc += dt * Aj; las[j * 129 + t] = acc; ldl[j * 129 + t] = __log2f(dt); } }
            ((float*)(A.ws + WS_ATOT))[((size_t)(b * 2 + (j >> 4)) * 16 + (j & 15)) * NCH + cid_all] = acc; }
        __syncthreads();
        float* LA = (float*)(A.ws + WS_LA); float* LD = (float*)(A.ws + WS_LD);
        for (int i = tid; i < 4096; i += NTHR) { const int j = i >> 7, t = i & 127; const size_t o = ((size_t)(b * 2 + (j >> 4)) * 16 + (j & 15)) * (NCH * 128) + cid_all * 128 + t;
            LA[o] = las[j * 129 + t]; LD[o] = ldl[j * 129 + t]; }
        __syncthreads();
    }
}
constexpr int SD_BS = 0, SD_CS = 32768, SD_HS = 65536, SD_LA = 81920, SD_BJ = SD_LA + 512, SD_W = SD_BJ + 512;
template <int IT>
__device__ __forceinline__ void ssd_y(lptr lds, const bf16x8 (&xf)[8], int dir, int pt, int r32, int hi, float dskip, bf16* yrow  ) {
    const LAS float* la_s = (const LAS float*)(lds + SD_LA); const LAS float* bj_s = (const LAS float*)(lds + SD_BJ);
    asm volatile("" : "+v"(r32), "+v"(hi));
    const float ai = la_s[32 * IT + r32];
    f32x16 accy;
#pragma unroll
    for (int r = 0; r < 16; ++r) accy[r] = 0.f;
#pragma unroll
    for (int s = 0; s < 8; ++s) {
        const bf16x8 a = *(const LAS bf16x8*)(lds + SD_CS + off_b(32 * IT + r32, 2 * s + hi));
        const bf16x8 bb = *(const LAS bf16x8*)(lds + SD_HS + off_b(32 * pt + r32, 2 * s + hi));
        accy = MFMA32(a, bb, accy);
    }
#pragma unroll
    for (int r = 0; r < 16; ++r) accy[r] *= __builtin_amdgcn_exp2f(la_s[32 * IT + crow(r, hi)]);
#pragma unroll
    for (int jt = 0; jt < 4; ++jt) {
        if (dir == 0 ? (jt <= IT) : (jt >= IT)) {
            asm volatile("" : "+v"(r32), "+v"(hi));
            f32x16 gt;
#pragma unroll
            for (int r = 0; r < 16; ++r) gt[r] = 0.f;
#pragma unroll
            for (int s = 0; s < 8; ++s) {
                const bf16x8 a = *(const LAS bf16x8*)(lds + SD_BS + off_b(32 * jt + r32, 2 * s + hi));
                const bf16x8 bb = *(const LAS bf16x8*)(lds + SD_CS + off_b(32 * IT + r32, 2 * s + hi));
                gt = MFMA32(a, bb, gt);
            }
#pragma unroll
            for (int r = 0; r < 16; ++r) { const int jl = crow(r, hi); const float bjv = bj_s[32 * jt + jl];
                const bool valid = (jt != IT) || (dir == 0 ? (jl <= r32) : (jl >= r32));
                gt[r] *= __builtin_amdgcn_exp2f(valid ? (ai - bjv) : -10000.f); }
            v4u u0, u1;
#pragma unroll
            for (int j = 0; j < 4; ++j) { u0[j] = cvtpk(gt[2 * j], gt[2 * j + 1]); u1[j] = cvtpk(gt[8 + 2 * j], gt[8 + 2 * j + 1]); }
            accy = MFMA32(__builtin_bit_cast(bf16x8, u0), xf[2 * jt], accy);
            accy = MFMA32(__builtin_bit_cast(bf16x8, u1), xf[2 * jt + 1], accy);
        }
    }
#pragma unroll
    for (int r = 0; r < 16; ++r) { const int il = crow(r, hi);
        float y = accy[r];
        if (dir == 0) { const int g4 = r >> 2, e = r & 3; const short xv = xf[2 * IT + (g4 >> 1)][4 * (g4 & 1) + e]; y += dskip * __uint_as_float(((unsigned)(unsigned short)xv) << 16); }
        yrow[(size_t)(32 * IT + il) * 1024] = (bf16)(cvtpk(y, 0.f) & 0xffffu); }
}
__device__ __forceinline__ void ssd_unit(const Args& A, lptr lds, int b, int h, int dir, int tid) {
    const int lane = tid & 63, w = __builtin_amdgcn_readfirstlane(tid >> 6), r32 = lane & 31, hi = lane >> 5, it = w >> 1, pt = w & 1, g = h >> 3;
    const bf16* BC = (const bf16*)(A.ws + WS_BC); const bf16* CC = (const bf16*)(A.ws + WS_CC); const bf16* XT = (const bf16*)(A.ws + WS_H);
    const float* LA = (const float*)(A.ws + WS_LA) + ((size_t)(b * 2 + dir) * 16 + h) * (NCH * 128);
    const float* LD = (const float*)(A.ws + WS_LD) + ((size_t)(b * 2 + dir) * 16 + h) * (NCH * 128);
    const float* ATOT = (const float*)(A.ws + WS_ATOT) + ((size_t)(b * 2 + dir) * 16 + h) * NCH;
    bf16* Y = (bf16*)(A.ws + (dir ? WS_YB : WS_YF));
    const float dskip = A.in[15][h];
    f32x16 st;
#pragma unroll
    for (int r = 0; r < 16; ++r) st[r] = 0.f;
    bf16x8 xf[8], xn[8]; v4u preB[4], preC[4]; float laN = 0.f, ldN = 0.f, atN = 0.f;
    const int q4 = (lane & 15) >> 2, p4 = lane & 3, blk = (lane >> 4) & 1;
#define SD_CID(k) (dir == 0 ? (k) : ((k) < 2 ? 1 - (k) : 35 - (k)))
#define SD_PREFETCH(k) do { const int ca_ = SD_CID(k); const bool cx_ = ca_ < 2; \
        const size_t rb_ = cx_ ? (size_t)M_LAT + b * CTXL + 128 * ca_ : (size_t)b * SEQ + 128 * (ca_ - 2); \
        _Pragma("unroll") for (int i_ = 0; i_ < 4; ++i_) { const int idx_ = tid + NTHR * i_, row_ = idx_ >> 4, ch_ = idx_ & 15; \
            preB[i_] = *(const GAS v4u*)(BC + (rb_ + row_) * 256 + g * 128 + ch_ * 8); \
            if (!cx_) preC[i_] = *(const GAS v4u*)(CC + (rb_ + row_) * 256 + g * 128 + ch_ * 8); } \
        const bf16* xp_ = XT + ((((size_t)b * NCH + ca_) * 16 + h) * 64 + 32 * pt + r32) * 128 + 8 * hi; \
        _Pragma("unroll") for (int s_ = 0; s_ < 8; ++s_) xn[s_] = *(const GAS bf16x8*)(xp_ + 16 * s_); \
        if (tid < 128) { laN = LA[ca_ * 128 + tid]; ldN = LD[ca_ * 128 + tid]; } atN = ATOT[ca_]; } while (0)
    SD_PREFETCH(0);
    for (int k = 0; k < NCH; ++k) {
        const int ca = SD_CID(k); const bool is_ctx = ca < 2;
        const float atot = atN;
#pragma unroll
        for (int i = 0; i < 4; ++i) { const int idx = tid + NTHR * i, row = idx >> 4, ch = idx & 15;
            *(LAS v4u*)(lds + SD_BS + off_b(row, ch)) = preB[i];
            if (!is_ctx) *(LAS v4u*)(lds + SD_CS + off_b(row, ch)) = preC[i]; }
        if (tid < 128) { ((LAS float*)(lds + SD_LA))[tid] = laN; ((LAS float*)(lds + SD_BJ))[tid] = laN - ldN; ((LAS float*)(lds + SD_W))[tid] = __builtin_amdgcn_exp2f(atot - laN + ldN); }
#pragma unroll
        for (int s = 0; s < 8; ++s) xf[s] = xn[s];
        if (!is_ctx) {
#pragma unroll
            for (int g4 = 0; g4 < 4; ++g4) { const unsigned lo = cvtpk(st[4 * g4], st[4 * g4 + 1]), hi2 = cvtpk(st[4 * g4 + 2], st[4 * g4 + 3]);
                const unsigned long long v = (unsigned long long)lo | ((unsigned long long)hi2 << 32);
                *(LAS unsigned long long*)(lds + SD_HS + off_b(32 * pt + r32, 4 * it + g4) + 8 * hi) = v; }
        }
        __syncthreads();
        if (k + 1 < NCH) SD_PREFETCH(k + 1);
        if (!is_ctx) {
            bf16* yrow = Y + ((size_t)b * SEQ + 128 * (ca - 2)) * 1024 + h * 64 + 32 * pt + r32;
            if (it == 0) ssd_y<0>(lds, xf, dir, pt, r32, hi, dskip, yrow);
            else if (it == 1) ssd_y<1>(lds, xf, dir, pt, r32, hi, dskip, yrow);
            else if (it == 2) ssd_y<2>(lds, xf, dir, pt, r32, hi, dskip, yrow);
            else ssd_y<3>(lds, xf, dir, pt, r32, hi, dskip, yrow);
        }
        { int hiv = hi, q4v = q4, p4v = p4; asm volatile("" : "+v"(hiv), "+v"(q4v), "+v"(p4v));
          const float dec = __builtin_amdgcn_exp2f(atot);
#pragma unroll
          for (int r = 0; r < 16; ++r) st[r] *= dec;
          const LAS float* w_s = (const LAS float*)(lds + SD_W);
#pragma unroll
          for (int s = 0; s < 8; ++s) {
              const unsigned ch = 4 * it + 2 * blk + (p4v >> 1);
              const s16x4 lo4 = trd(lds + SD_BS + off_b(16 * s + 4 * hiv + q4v, ch) + 8 * (p4v & 1));
              const s16x4 hi4 = trd(lds + SD_BS + off_b(16 * s + 8 + 4 * hiv + q4v, ch) + 8 * (p4v & 1));
              const f32x4 w0 = *(const LAS f32x4*)(w_s + 16 * s + 4 * hiv), w1 = *(const LAS f32x4*)(w_s + 16 * s + 8 + 4 * hiv);
              const v4u xu = __builtin_bit_cast(v4u, xf[s]); v4u xs;
              xs.x = cvtpk(bflo(xu.x) * w0[0], bfhi(xu.x) * w0[1]); xs.y = cvtpk(bflo(xu.y) * w0[2], bfhi(xu.y) * w0[3]);
              xs.z = cvtpk(bflo(xu.z) * w1[0], bfhi(xu.z) * w1[1]); xs.w = cvtpk(bflo(xu.w) * w1[2], bfhi(xu.w) * w1[3]);
              st = MFMA32(cat8(lo4, hi4), __builtin_bit_cast(bf16x8, xs), st);
          } }
        __syncthreads();
    }
#undef SD_CID
#undef SD_PREFETCH
}
__device__ __forceinline__ void gate_phase(const Args& A, int tid, int vcu, int G) {
    const int lane = tid & 63, wave = tid >> 6, gw = vcu * NWAVES + wave, NGW = G * NWAVES;
    const bf16* YF = (const bf16*)(A.ws + WS_YF); const bf16* YB = (const bf16*)(A.ws + WS_YB); bf16* ZQ = (bf16*)(A.ws + WS_ZQ);
    const float* nw = A.in[16];
    for (int r = gw; r < M_LAT; r += NGW) {
        float gv[16]; float s = 0.f;
#pragma unroll
        for (int j = 0; j < 2; ++j) { const int c = 8 * lane + 512 * j;
            const v4u yf = *(const GAS v4u*)(YF + (size_t)r * 1024 + c), yb = *(const GAS v4u*)(YB + (size_t)r * 1024 + c), z = *(const GAS v4u*)(ZQ + (size_t)r * 2048 + c);
#pragma unroll
            for (int e = 0; e < 4; ++e) { const float y0 = bflo(yf[e]) + bflo(yb[e]), y1 = bfhi(yf[e]) + bfhi(yb[e]);
                const float g0 = y0 * silu_f(bflo(z[e])), g1 = y1 * silu_f(bfhi(z[e])); gv[8 * j + 2 * e] = g0; gv[8 * j + 2 * e + 1] = g1; s += g0 * g0 + g1 * g1; } }
        const float rstd = rsqrtf(wave_sum(s) * (1.f / 1024.f) + RMS_EPS);
#pragma unroll
        for (int j = 0; j < 2; ++j) { const int c = 8 * lane + 512 * j; v4u o;
#pragma unroll
            for (int e = 0; e < 4; ++e) o[e] = cvtpk(gv[8 * j + 2 * e] * rstd * nw[c + 2 * e], gv[8 * j + 2 * e + 1] * rstd * nw[c + 2 * e + 1]);
            *(GAS v4u*)(ZQ + (size_t)r * 2048 + c) = o; }
    }
}
__device__ __forceinline__ void conv1_phase(const Args& A, int tid, int vcu, int G) {
    const bf16* P1 = (const bf16*)(A.ws + WS_P1); bf16* G1 = (bf16*)(A.ws + WS_G1); const float* cw = A.in[20];
    const long gt = (long)vcu * NTHR + tid, NGT = (long)G * NTHR;
    for (long item = gt; item < (long)M_LAT * 128; item += NGT) {
        const int r = (int)(item >> 7), c0 = (int)(item & 127) * 8, t = r & (SEQ - 1);
        float acc[8];
#pragma unroll
        for (int e = 0; e < 8; ++e) acc[e] = 0.f;
#pragma unroll
        for (int k = 0; k < 3; ++k) { const int tt = t + k - 1;
            if (tt >= 0 && tt < SEQ) { const bf16* src = P1 + (size_t)(r + k - 1) * 3072 + c0; const v4u gc = *(const GAS v4u*)(src + 1024), vl = *(const GAS v4u*)(src + 2048); const float* wk = cw + k * 1024 + c0;
#pragma unroll
                for (int e = 0; e < 4; ++e) { acc[2 * e] += wk[2 * e] * bflo(gc[e]) * bflo(vl[e]); acc[2 * e + 1] += wk[2 * e + 1] * bfhi(gc[e]) * bfhi(vl[e]); } } }
        const v4u gb = *(const GAS v4u*)(P1 + (size_t)r * 3072 + c0); v4u o;
#pragma unroll
        for (int e = 0; e < 4; ++e) o[e] = cvtpk(bflo(gb[e]) * acc[2 * e], bfhi(gb[e]) * acc[2 * e + 1]);
        *(GAS v4u*)(G1 + (size_t)r * 1024 + c0) = o;
    }
}
#define MK_MODE 0
constexpr int N_PHASES = 18;
__global__ void __launch_bounds__(NTHR, 2) mk_fwd(Args args) {
    extern __shared__ __attribute__((aligned(16))) unsigned char lds_raw[];
    lptr lds = (lptr)lds_raw;
    const int tid = threadIdx.x, G = gridDim.x;
    const int bx = blockIdx.x, vcu = (G % 8 == 0) ? (bx % 8) * (G / 8) + bx / 8 : bx;
    unsigned char* ws = args.ws;
    const int lo = args.ph_lo, hi = args.ph_hi;
    for (int u = tid; u < (LDS_BYTES - LDSCTL_OFF) / 4; u += NTHR) ((LAS unsigned*)(lds + LDSCTL_OFF))[u] = 0u;
    __syncthreads();
    XcdBarrier bar; bar.bar = (unsigned*)(ws + WS_CTL); bar.x = 0; bar.st = nullptr;
    if (hi - lo > 1 && !args.use_cg) bar = xcd_barrier_post((unsigned*)(ws + WS_CTL), (volatile LAS unsigned*)(lds + MISC_OFF) + 8);
#ifndef PH_MASK
#define PH_MASK 0x3ffff
#endif
#define IN(k) (((PH_MASK >> (k)) & 1) && lo <= (k) && (k) < hi)
#define SEAM(k) do { if (IN(k) && IN((k) + 1)) { if (args.use_cg) { cg::this_grid().sync(); } else { xcd_barrier(bar); } } } while (0)
    const float* MOD = (const float*)(ws + WS_MOD);
    bf16* H = (bf16*)(ws + WS_H);

    if (IN(0)) { p0_prologue(args, lds, tid, vcu, G); } SEAM(0);
    if (IN(1)) { norm_phase(args, args.in[0], args.in[6], 0, 0, true, tid, vcu, G); } SEAM(1);
    if (IN(2)) {
        pg8::Gemm g{H, (const bf16*)(ws + WS_WIN), M_ALL, NIN0, D}; pg8::InProjOrder S{G, bx};
        pg8::EpiInProj E{(bf16*)(ws + WS_XBC), (bf16*)(ws + WS_ZQ), (bf16*)(ws + WS_KV), (float*)(ws + WS_DTRAW)};
        pg8::gemm_phase<pg8::EpiInProj, pg8::InProjOrder, true, true>(lds, g, S, E);
    } SEAM(2);
    if (IN(3)) {
        for (int u = vcu; u < 2048; u += G) { const int band = u & 15, hh = (u >> 4) & 15, b = u >> 8; na_unit(args, lds, b, hh, band, tid); }
        for (int u = vcu; u < BATCH * NCH; u += G) prep_unit(args, lds, u, tid);
    } SEAM(3);
    if (IN(4)) {
        for (int u = bx; u < 256; u += G) { const int b = u & 7, j = u >> 3; ssd_unit(args, lds, b, j & 15, j >> 4, tid); }
    } SEAM(4);
    if (IN(5)) { gate_phase(args, tid, vcu, G); late_weights(args, lds, tid, vcu, G); } SEAM(5);
    if (IN(6)) {
        pg8::Gemm g{(const bf16*)(ws + WS_ZQ), (const bf16*)(ws + WS_WOUT), M_LAT, D, 2 * D}; pg8::StaticOrder S; S.init(M_LAT, D, G, bx);
        pg8::EpiResid E{args.in[0], args.out, MOD + 2 * D, 6 * D};
        pg8::gemm_phase<pg8::EpiResid, pg8::StaticOrder, true, true>(lds, g, S, E);
    } SEAM(6);
    if (IN(7)) { norm_phase(args, args.out, args.in[7], 0, 1, false, tid, vcu, G); } SEAM(7);
    if (IN(8)) {
        pg8::Gemm g{H, (const bf16*)(ws + WS_W1T0), M_LAT, DFF, D}; pg8::StaticOrder S; S.init(M_LAT, DFF, G, bx);
        pg8::EpiBf16Act<1> E{(bf16*)(ws + WS_HID), DFF};
        pg8::gemm_phase<pg8::EpiBf16Act<1>, pg8::StaticOrder, true, true>(lds, g, S, E);
    } SEAM(8);
    if (IN(9)) {
        pg8::Gemm g{(const bf16*)(ws + WS_HID), (const bf16*)(ws + WS_W2T0), M_LAT, D, DFF}; pg8::StaticOrder S; S.init(M_LAT, D, G, bx);
        pg8::EpiResid E{args.out, args.out, MOD + 5 * D, 6 * D};
        pg8::gemm_phase<pg8::EpiResid, pg8::StaticOrder, true, true>(lds, g, S, E);
    } SEAM(9);
    if (IN(10)) { norm_phase(args, args.out, args.in[6] + D, 1, 0, false, tid, vcu, G); } SEAM(10);
    if (IN(11)) {
        pg8::Gemm g{H, (const bf16*)(ws + WS_SCIN), M_LAT, 3 * D, D}; pg8::StaticOrder S; S.init(M_LAT, 3 * D, G, bx);
        pg8::EpiBf16Act<0> E{(bf16*)(ws + WS_P1), 3 * D};
        pg8::gemm_phase<pg8::EpiBf16Act<0>, pg8::StaticOrder, true, true>(lds, g, S, E);
    } SEAM(11);
    if (IN(12)) { conv1_phase(args, tid, vcu, G); } SEAM(12);
    if (IN(13)) {
        pg8::Gemm g{(const bf16*)(ws + WS_G1), (const bf16*)(ws + WS_SCOUT), M_LAT, D, D}; pg8::StaticOrder S; S.init(M_LAT, D, G, bx);
        pg8::EpiResid E{args.out, args.out, MOD + (size_t)8 * 6 * D + 2 * D, 6 * D};
        pg8::gemm_phase<pg8::EpiResid, pg8::StaticOrder, true, true>(lds, g, S, E);
    } SEAM(13);
    if (IN(14)) { norm_phase(args, args.out, args.in[7] + D, 1, 1, false, tid, vcu, G); } SEAM(14);
    if (IN(15)) {
        pg8::Gemm g{H, (const bf16*)(ws + WS_W1T1), M_LAT, DFF, D}; pg8::StaticOrder S; S.init(M_LAT, DFF, G, bx);
        pg8::EpiBf16Act<1> E{(bf16*)(ws + WS_HID), DFF};
        pg8::gemm_phase<pg8::EpiBf16Act<1>, pg8::StaticOrder, true, true>(lds, g, S, E);
    } SEAM(15);
    if (IN(16)) {
        pg8::Gemm g{(const bf16*)(ws + WS_HID), (const bf16*)(ws + WS_W2T1), M_LAT, D, DFF}; pg8::StaticOrder S; S.init(M_LAT, D, G, bx);
        pg8::EpiResid E{args.out, args.out, MOD + (size_t)8 * 6 * D + 5 * D, 6 * D};
        pg8::gemm_phase<pg8::EpiResid, pg8::StaticOrder, true, true>(lds, g, S, E);
    } SEAM(16);
    if (IN(17)) { final_norm_phase(args, tid, vcu, G); }
#undef IN
#undef SEAM
}

#ifndef MK_MODE
#define MK_MODE 0
#endif
extern "C" void kernel_launch(void* const* d_in, const int* in_sizes, int n_in, void* d_out, int out_size, void* d_ws, size_t ws_size, hipStream_t stream) {
    static int grid = 0;
    if (grid == 0) {
        if (n_in != 23 || out_size != M_LAT * D || ws_size < WS_END) { fprintf(stderr, "kernel_launch: unexpected problem shape (n_in %d out %d ws %zu)\n", n_in, out_size, ws_size); grid = -1; return; }
        int dev = 0, cus = 0, per_cu = 0;
        if (hipGetDevice(&dev) != hipSuccess || hipDeviceGetAttribute(&cus, hipDeviceAttributeMultiprocessorCount, dev) != hipSuccess) { grid = -1; return; }
        if (hipFuncSetAttribute((const void*)mk_fwd, hipFuncAttributeMaxDynamicSharedMemorySize, LDS_BYTES) != hipSuccess) { fprintf(stderr, "kernel_launch: hipFuncSetAttribute failed\n"); grid = -1; return; }
        if (hipOccupancyMaxActiveBlocksPerMultiprocessor(&per_cu, (const void*)mk_fwd, NTHR, LDS_BYTES) != hipSuccess || per_cu < 1) { fprintf(stderr, "kernel_launch: occupancy query says %d\n", per_cu); per_cu = 1; }
        (void)hipGetLastError();
        grid = cus;
    }
    if (grid < 0) return;
    (void)hipMemsetAsync((char*)d_ws + WS_CTL, 0, CTL_ZERO_BYTES, stream);
    Args a{};
    for (int i = 0; i < 23; ++i) a.in[i] = (const float*)d_in[i];
    a.out = (float*)d_out; a.ws = (unsigned char*)d_ws;
#if MK_MODE == 0
    for (int p = 0; p < N_PHASES; ++p) { a.ph_lo = p; a.ph_hi = p + 1; a.use_cg = 0; hipLaunchKernelGGL(mk_fwd, dim3(grid), dim3(NTHR), LDS_BYTES, stream, a); }
#else
    a.ph_lo = 0; a.ph_hi = N_PHASES; a.use_cg = (MK_MODE == 1) ? 1 : 0;
    void* kargs[] = {&a};
    hipError_t e = hipLaunchCooperativeKernel((const void*)mk_fwd, dim3(grid), dim3(NTHR), kargs, LDS_BYTES, stream);
    if (e != hipSuccess) fprintf(stderr, "kernel_launch: cooperative launch failed: %s (grid %d)\n", hipGetErrorString(e), grid);
#endif
}
```

```cpp
#include <hip/hip_runtime.h>
#include <hip/hip_cooperative_groups.h>
#include <cstdio>
#include <cstdint>
namespace pg8 {
#define PG8_LAS __attribute__((address_space(3)))
typedef unsigned short bf16_t;
typedef short bf16x8 __attribute__((ext_vector_type(8)));
typedef float f32x4 __attribute__((ext_vector_type(4)));
typedef unsigned u32x4 __attribute__((ext_vector_type(4)));
constexpr int BM = 256, BK = 64, HALF = 128, HTB = HALF * BK * 2  , STAGE_BYTES = 8 * HTB, NXCD = 8, WGM = 8;

__host__ __device__ __forceinline__ int lds_byte(int r, int c) { const int st = (r >> 4) * 2 + (c >> 5), rr = r & 15, cc = c & 31, ob = rr * 64 + cc * 2; return st * 1024 + (ob ^ (((ob >> 9) & 1) << 5)); }
__host__ __device__ __forceinline__ void stage_rc(int b, int& R, int& C) { const int st = b / 1024, sb = b % 1024, swz = sb ^ (((sb >> 9) & 1) << 5); R = (st >> 1) * 16 + swz / 64; C = (st & 1) * 32 + (swz % 64) / 2; }
__host__ __device__ __forceinline__ int perm32(int rho) { const int n = rho >> 4, i = rho & 15; return 8 * (i >> 2) + 4 * n + (i & 3); }

struct Unit { int pm, pn; };
struct Gemm { const bf16_t* A; const bf16_t* Bt; int M, N, K; };

struct StaticOrder {
    int nM, nN, nwg, G, c;
    __host__ __device__ void init(int M, int N, int G_, int c_) { nM = M / BM; nN = N / BM; nwg = nM * nN; G = G_; c = c_; }
    __host__ __device__ bool next(int i, Unit& u) const {
        const long L = (long)i * G + c; if (L >= nwg) return false;
        int wgid = (int)L; { const int q = nwg / NXCD, r = nwg % NXCD, xcd = wgid % NXCD, off = wgid / NXCD; wgid = (xcd < r ? xcd * (q + 1) : r * (q + 1) + (xcd - r) * q) + off; }
        const int nig = WGM * nN, gid = wgid / nig, fm = gid * WGM, gsz = (nM - fm) < WGM ? (nM - fm) : WGM;
        u.pm = fm + ((wgid % nig) % gsz); u.pn = (wgid % nig) / gsz; return true;
    }
    __device__ __forceinline__ void a_ready(const Unit&) const {}
    __device__ __forceinline__ void done(const Unit&) const {}
};

__device__ __forceinline__ unsigned cvt_pk_bf16(float lo, float hi) { unsigned r; asm volatile("v_cvt_pk_bf16_f32 %0, %1, %2" : "=v"(r) : "v"(lo), "v"(hi)); return r; }
typedef float f32x2 __attribute__((ext_vector_type(2)));
constexpr float NA_C2 = 0.125f * 1.4426950408889634f;
#ifndef EPI_WT
#define EPI_WT 1
#endif
__device__ __forceinline__ void st16(void* p, u32x4 v) {
#if EPI_WT
    asm volatile("global_store_dwordx4 %0, %1, off sc1\n\ts_nop 1" :: "v"(p), "v"(v) : "memory");
#else
    *(u32x4*)p = v;
#endif
}
__device__ __forceinline__ void st16f(float* p, f32x4 v) { st16((void*)p, __builtin_bit_cast(u32x4, v)); }
__device__ __forceinline__ void st8(void* p, unsigned lo, unsigned hi) {
#if EPI_WT
    typedef unsigned u32x2_ __attribute__((ext_vector_type(2))); const u32x2_ v = {lo, hi};
    asm volatile("global_store_dwordx2 %0, %1, off sc1" :: "v"(p), "v"(v) : "memory");
#else
    typedef unsigned u32x2_ __attribute__((ext_vector_type(2))); *(u32x2_*)p = (u32x2_){lo, hi};
#endif
}
__device__ __forceinline__ u32x4 pack8(f32x4 v0, f32x4 v1) { u32x4 w; w.x = cvt_pk_bf16(v0[0], v0[1]); w.y = cvt_pk_bf16(v0[2], v0[3]); w.z = cvt_pk_bf16(v1[0], v1[1]); w.w = cvt_pk_bf16(v1[2], v1[3]); return w; }

struct EpiNoPre {};
struct EpiInProj {
    static constexpr bool PERM = true, AFTER_DRAIN = false; typedef EpiNoPre Pre;
    __device__ __forceinline__ void pre(Pre&, const Unit&, int, int, int, int) const {}
    bf16_t* xbc; bf16_t* zq; bf16_t* kv; float* dtraw;
    __device__ __forceinline__ void operator()(const f32x4 (&acc)[2][2][4][2], const Unit& u, int wr, int wc, int fr, int fq, const Pre&) const {
        const int row0 = u.pm * BM + wr * 64 + fr; const int pn = u.pn;
        if (pn == 22) {
            if (wc == 0) {
#pragma unroll
                for (int ai = 0; ai < 2; ++ai)
#pragma unroll
                    for (int m = 0; m < 4; ++m) { float* rp = dtraw + (size_t)(row0 + ai * HALF + m * 16) * 32 + 8 * fq;
                        *(f32x4*)rp = acc[ai][0][m][0]; *(f32x4*)(rp + 4) = acc[ai][0][m][1]; }
            }
            return;
        }
        bf16_t* base; int ldc, colt; float sc = 1.f;
        if (pn < 6) { base = xbc; ldc = 1536; colt = pn * 256; }
        else if (pn < 14) { base = zq; ldc = 2048; colt = (pn - 6) * 256; if (pn >= 10) sc = NA_C2; }
        else { base = kv; ldc = 2048; colt = (pn - 14) * 256; }
        const int col0 = colt + wc * 32 + 8 * fq;
#pragma unroll
        for (int ai = 0; ai < 2; ++ai)
#pragma unroll
            for (int m = 0; m < 4; ++m) { bf16_t* rowp = base + (size_t)(row0 + ai * HALF + m * 16) * ldc + col0;
#pragma unroll
                for (int bj = 0; bj < 2; ++bj) st16(rowp + bj * HALF, pack8(acc[ai][bj][m][0] * sc, acc[ai][bj][m][1] * sc)); }
    }
};
template <int ACT, bool NORM> struct EpiBf16Act {
    static constexpr bool PERM = true, AFTER_DRAIN = false;
    bf16_t* O; int ldc; const float* ss; const float* biasb; int bstride;
    struct Pre { };
    __device__ __forceinline__ void pre(Pre& p, const Unit& u, int wr, int wc, int fr, int fq) const {
        if (NORM) {
            const int row0 = u.pm * BM + wr * 64 + fr, col0 = u.pn * BM + wc * 32 + 8 * fq;
            (void)row0; (void)col0; (void)p;
        }
    }
    __device__ __forceinline__ void operator()(const f32x4 (&acc)[2][2][4][2], const Unit& u, int wr, int wc, int fr, int fq, const Pre& p) const {
        const int row0 = u.pm * BM + wr * 64 + fr, col0 = u.pn * BM + wc * 32 + 8 * fq;
        float rs[2][4]; f32x4 bv[2][2];
        if (NORM) {
            const float* bp = biasb + (size_t)(u.pm >> 4) * bstride + col0;
#pragma unroll
            for (int bj = 0; bj < 2; ++bj) { bv[bj][0] = *(const f32x4*)(bp + bj * HALF); bv[bj][1] = *(const f32x4*)(bp + bj * HALF + 4); }
#pragma unroll
            for (int ai = 0; ai < 2; ++ai)
#pragma unroll
                for (int m = 0; m < 4; ++m) rs[ai][m] = __builtin_amdgcn_rsqf(ss[row0 + ai * HALF + m * 16] * (1.f / 1024.f) + 1e-6f);
        }
#pragma unroll
        for (int ai = 0; ai < 2; ++ai)
#pragma unroll
            for (int m = 0; m < 4; ++m) { bf16_t* rowp = O + (size_t)(row0 + ai * HALF + m * 16) * ldc + col0;
#pragma unroll
                for (int bj = 0; bj < 2; ++bj) { f32x4 v0 = acc[ai][bj][m][0], v1 = acc[ai][bj][m][1];
                    if (NORM) { v0 = v0 * rs[ai][m] + bv[bj][0]; v1 = v1 * rs[ai][m] + bv[bj][1]; }
                    if (ACT == 1) { v0 = __builtin_elementwise_max(v0, (f32x4){0.f, 0.f, 0.f, 0.f}); v1 = __builtin_elementwise_max(v1, (f32x4){0.f, 0.f, 0.f, 0.f}); v0 = v0 * v0; v1 = v1 * v1; }
                    st16(rowp + bj * HALF, pack8(v0, v1)); } }
    }
};
struct EpiScIn {
    static constexpr bool PERM = true, AFTER_DRAIN = false; typedef EpiNoPre Pre;
    __device__ __forceinline__ void pre(Pre&, const Unit&, int, int, int, int) const {}
    bf16_t* O; const float* ss; const float* biasb; int bstride;
    __device__ __forceinline__ void operator()(const f32x4 (&acc)[2][2][4][2], const Unit& u, int wr, int wc, int fr, int fq, const Pre&) const {
        const int row0 = u.pm * BM + wr * 64 + fr, col0 = u.pn * BM + wc * 32 + 8 * fq;
        float rs[2][4]; f32x4 bv[2][2];
        const float* bp = biasb + (size_t)(u.pm >> 4) * bstride + col0;
#pragma unroll
        for (int bj = 0; bj < 2; ++bj) { bv[bj][0] = *(const f32x4*)(bp + bj * HALF); bv[bj][1] = *(const f32x4*)(bp + bj * HALF + 4); }
#pragma unroll
        for (int ai = 0; ai < 2; ++ai)
#pragma unroll
            for (int m = 0; m < 4; ++m) rs[ai][m] = __builtin_amdgcn_rsqf(ss[row0 + ai * HALF + m * 16] * (1.f / 1024.f) + 1e-6f);
        if (u.pn < 4) {
#pragma unroll
            for (int ai = 0; ai < 2; ++ai)
#pragma unroll
                for (int m = 0; m < 4; ++m) { bf16_t* rowp = O + (size_t)(row0 + ai * HALF + m * 16) * 2048 + col0;
#pragma unroll
                    for (int bj = 0; bj < 2; ++bj) st16(rowp + bj * HALF, pack8(acc[ai][bj][m][0] * rs[ai][m] + bv[bj][0], acc[ai][bj][m][1] * rs[ai][m] + bv[bj][1])); }
        } else {
            const int ucol = 1024 + (u.pn - 4) * HALF + wc * 32 + 8 * fq;
#pragma unroll
            for (int ai = 0; ai < 2; ++ai)
#pragma unroll
                for (int m = 0; m < 4; ++m) { bf16_t* rowp = O + (size_t)(row0 + ai * HALF + m * 16) * 2048 + ucol;
                    const f32x4 c0 = acc[ai][0][m][0] * rs[ai][m] + bv[0][0], c1 = acc[ai][0][m][1] * rs[ai][m] + bv[0][1];
                    const f32x4 v0 = acc[ai][1][m][0] * rs[ai][m] + bv[1][0], v1 = acc[ai][1][m][1] * rs[ai][m] + bv[1][1];
                    st16(rowp, pack8(c0 * v0, c1 * v1)); }
        }
    }
};
template <int STMODE> struct EpiProbeAct {
    static constexpr bool PERM = true, AFTER_DRAIN = false; typedef EpiNoPre Pre;
    __device__ __forceinline__ void pre(Pre&, const Unit&, int, int, int, int) const {}
    bf16_t* O; int ldc; const float* ss; const float* biasb; int bstride;
    __device__ __forceinline__ void operator()(const f32x4 (&acc)[2][2][4][2], const Unit& u, int wr, int wc, int fr, int fq, const Pre&) const {
        const int row0 = u.pm * BM + wr * 64 + fr, col0 = u.pn * BM + wc * 32 + 8 * fq;
        float rs[2][4]; f32x4 bv[2][2];
        const float* bp = biasb + (size_t)(u.pm >> 4) * bstride + col0;
#pragma unroll
        for (int bj = 0; bj < 2; ++bj) { bv[bj][0] = *(const f32x4*)(bp + bj * HALF); bv[bj][1] = *(const f32x4*)(bp + bj * HALF + 4); }
#pragma unroll
        for (int ai = 0; ai < 2; ++ai)
#pragma unroll
            for (int m = 0; m < 4; ++m) rs[ai][m] = __builtin_amdgcn_rsqf(ss[row0 + ai * HALF + m * 16] * (1.f / 1024.f) + 1e-6f);
#pragma unroll
        for (int ai = 0; ai < 2; ++ai)
#pragma unroll
            for (int m = 0; m < 4; ++m) {
                bf16_t* rowp = (STMODE == 1) ? O + (size_t)(((u.pm & 1) * 8 + ai * 4 + m) * 16 + fr) * 256 + wc * 32 + 8 * fq
                                             : O + (size_t)(row0 + ai * HALF + m * 16) * ldc + col0;
#pragma unroll
                for (int bj = 0; bj < 2; ++bj) { f32x4 v0 = acc[ai][bj][m][0] * rs[ai][m] + bv[bj][0], v1 = acc[ai][bj][m][1] * rs[ai][m] + bv[bj][1];
                    v0 = __builtin_elementwise_max(v0, (f32x4){0.f, 0.f, 0.f, 0.f}); v1 = __builtin_elementwise_max(v1, (f32x4){0.f, 0.f, 0.f, 0.f}); v0 = v0 * v0; v1 = v1 * v1;
                    const u32x4 pk = pack8(v0, v1);
                    if (STMODE == 1 || (pk.x == 0x12345678u && pk.w == 0x9abcdef0u)) *(u32x4*)(rowp + bj * HALF) = pk; } }
    }
};
struct EpiNull {
    static constexpr bool PERM = true, AFTER_DRAIN = false; typedef EpiNoPre Pre;
    __device__ __forceinline__ void pre(Pre&, const Unit&, int, int, int, int) const {}
    float* sink;
    __device__ __forceinline__ void operator()(const f32x4 (&acc)[2][2][4][2], const Unit& u, int wr, int wc, int fr, int fq, const Pre&) const {
        float s = 0.f;
#pragma unroll
        for (int ai = 0; ai < 2; ++ai)
#pragma unroll
            for (int bj = 0; bj < 2; ++bj)
#pragma unroll
                for (int m = 0; m < 4; ++m)
#pragma unroll
                    for (int n = 0; n < 2; ++n) s += (acc[ai][bj][m][n][0] + acc[ai][bj][m][n][1]) + (acc[ai][bj][m][n][2] + acc[ai][bj][m][n][3]);
        if (s == 123456.789f) sink[u.pm * 7 + u.pn + wr + wc + fr + fq] = s;
    }
};
template <bool NEXT, bool RIN_F32> struct EpiResid {
    static constexpr bool PERM = true, AFTER_DRAIN = false; typedef EpiNoPre Pre;
    __device__ __forceinline__ void pre(Pre&, const Unit&, int, int, int, int) const {}
    const void* resid; bf16_t* out; const float* gate; int gstride; bf16_t* an; const float* wsv; float* ssq;
    __device__ __forceinline__ void operator()(const f32x4 (&acc)[2][2][4][2], const Unit& u, int wr, int wc, int fr, int fq, const Pre&) const {
        const int row0 = u.pm * BM + wr * 64 + fr, col0 = u.pn * BM + wc * 32 + 8 * fq;
        const float* gp = gate + (size_t)(u.pm >> 4) * gstride + col0;
        f32x4 gv[2][2], wv[2][2];
#pragma unroll
        for (int bj = 0; bj < 2; ++bj)
#pragma unroll
            for (int n = 0; n < 2; ++n) { gv[bj][n] = *(const f32x4*)(gp + bj * HALF + n * 4); if (NEXT) wv[bj][n] = *(const f32x4*)(wsv + (size_t)(u.pm >> 4) * 1024 + col0 + bj * HALF + n * 4); }
        constexpr int NB = RIN_F32 ? 4 : 2, MB = RIN_F32 ? 2 : 4;
#pragma unroll
        for (int bt = 0; bt < NB; ++bt) { const int ai = RIN_F32 ? (bt >> 1) : bt, mb = RIN_F32 ? 2 * (bt & 1) : 0;
            f32x4 rr[RIN_F32 ? MB : 1][2][2]; u32x4 rq[RIN_F32 ? 1 : MB][2];
#pragma unroll
            for (int m2 = 0; m2 < MB; ++m2) { const size_t off = (size_t)(row0 + ai * HALF + (mb + m2) * 16) * 1024 + col0;
#pragma unroll
                for (int bj = 0; bj < 2; ++bj) {
                    if (RIN_F32) { rr[RIN_F32 ? m2 : 0][bj][0] = *(const f32x4*)((const float*)resid + off + bj * HALF); rr[RIN_F32 ? m2 : 0][bj][1] = *(const f32x4*)((const float*)resid + off + bj * HALF + 4); }
                    else rq[RIN_F32 ? 0 : m2][bj] = *(const u32x4*)((const bf16_t*)resid + off + bj * HALF); } }
            asm volatile("" ::: "memory");
#pragma unroll
            for (int m2 = 0; m2 < MB; ++m2) { const int m = mb + m2; const int row = row0 + ai * HALF + m * 16; const size_t off = (size_t)row * 1024 + col0; float sq = 0.f;
#pragma unroll
                for (int bj = 0; bj < 2; ++bj) {
                    f32x4 r0, r1;
                    if (RIN_F32) { r0 = rr[RIN_F32 ? m2 : 0][bj][0]; r1 = rr[RIN_F32 ? m2 : 0][bj][1]; }
                    else { const u32x4 q = rq[RIN_F32 ? 0 : m2][bj];
                        r0 = (f32x4){__uint_as_float(q.x << 16), __uint_as_float(q.x & 0xffff0000u), __uint_as_float(q.y << 16), __uint_as_float(q.y & 0xffff0000u)};
                        r1 = (f32x4){__uint_as_float(q.z << 16), __uint_as_float(q.z & 0xffff0000u), __uint_as_float(q.w << 16), __uint_as_float(q.w & 0xffff0000u)}; }
                    const f32x4 o0 = r0 + gv[bj][0] * acc[ai][bj][m][0], o1 = r1 + gv[bj][1] * acc[ai][bj][m][1];
                    *(u32x4*)(out + off + bj * HALF) = pack8(o0, o1);
                    if (NEXT) { sq += ((o0[0] * o0[0] + o0[1] * o0[1]) + (o0[2] * o0[2] + o0[3] * o0[3])) + ((o1[0] * o1[0] + o1[1] * o1[1]) + (o1[2] * o1[2] + o1[3] * o1[3]));
                        *(u32x4*)(an + off + bj * HALF) = pack8(o0 * wv[bj][0], o1 * wv[bj][1]); } }
                if (NEXT) { sq += __shfl_xor(sq, 16); sq += __shfl_xor(sq, 32); if (fq == 0) atomicAdd(ssq + row, sq); } }
        }
    }
};
struct EpiResidFinal {
    static constexpr bool PERM = true, AFTER_DRAIN = false; typedef EpiNoPre Pre;
    __device__ __forceinline__ void pre(Pre&, const Unit&, int, int, int, int) const {}
    const bf16_t* resid; float* out; const float* gate; int gstride; const float* nw; float* ssq; unsigned* cnt;
    __device__ __forceinline__ void operator()(f32x4 (&acc)[2][2][4][2], const Unit& u, int wr, int wc, int fr, int fq, const Pre&) const {
        const int row0 = u.pm * BM + wr * 64 + fr, col0 = u.pn * BM + wc * 32 + 8 * fq;
        const float* gp = gate + (size_t)(u.pm >> 4) * gstride + col0;
        f32x4 gv[2][2];
#pragma unroll
        for (int bj = 0; bj < 2; ++bj)
#pragma unroll
            for (int n = 0; n < 2; ++n) gv[bj][n] = *(const f32x4*)(gp + bj * HALF + n * 4);
        float part[2][4];
#pragma unroll
        for (int ai = 0; ai < 2; ++ai) {
            u32x4 rq[4][2];
#pragma unroll
            for (int m = 0; m < 4; ++m) { const size_t off = (size_t)(row0 + ai * HALF + m * 16) * 1024 + col0;
#pragma unroll
                for (int bj = 0; bj < 2; ++bj) rq[m][bj] = *(const u32x4*)(resid + off + bj * HALF); }
#pragma unroll
            for (int m = 0; m < 4; ++m) { float sq = 0.f;
#pragma unroll
                for (int bj = 0; bj < 2; ++bj) { const u32x4 q = rq[m][bj];
                    const f32x4 r0 = (f32x4){__uint_as_float(q.x << 16), __uint_as_float(q.x & 0xffff0000u), __uint_as_float(q.y << 16), __uint_as_float(q.y & 0xffff0000u)};
                    const f32x4 r1 = (f32x4){__uint_as_float(q.z << 16), __uint_as_float(q.z & 0xffff0000u), __uint_as_float(q.w << 16), __uint_as_float(q.w & 0xffff0000u)};
                    const f32x4 o0 = r0 + gv[bj][0] * acc[ai][bj][m][0], o1 = r1 + gv[bj][1] * acc[ai][bj][m][1]; acc[ai][bj][m][0] = o0; acc[ai][bj][m][1] = o1;
                    sq += ((o0[0] * o0[0] + o0[1] * o0[1]) + (o0[2] * o0[2] + o0[3] * o0[3])) + ((o1[0] * o1[0] + o1[1] * o1[1]) + (o1[2] * o1[2] + o1[3] * o1[3])); }
                sq += __shfl_xor(sq, 16); sq += __shfl_xor(sq, 32); part[ai][m] = sq; } }
        float got = 0.f;
        if (fq == 0) {
#pragma unroll
            for (int ai = 0; ai < 2; ++ai)
#pragma unroll
                for (int m = 0; m < 4; ++m) got += __hip_atomic_fetch_add(ssq + row0 + ai * HALF + m * 16, part[ai][m], __ATOMIC_RELAXED, __HIP_MEMORY_SCOPE_AGENT);
        }
        asm volatile("s_waitcnt vmcnt(0)" : "+v"(got) :: "memory");
        unsigned* cw = cnt + 64 * u.pm;
        if ((threadIdx.x & 63) == 0) __hip_atomic_fetch_add(cw, 1u, __ATOMIC_RELAXED, __HIP_MEMORY_SCOPE_AGENT);
        { unsigned spins = 0;
          while ((unsigned)__builtin_amdgcn_readfirstlane((int)__hip_atomic_load(cw, __ATOMIC_RELAXED, __HIP_MEMORY_SCOPE_AGENT)) < 32u) { __builtin_amdgcn_s_sleep(4); if (++spins > (1u << 20)) break; } }
        asm volatile("s_waitcnt vmcnt(0)" ::: "memory");
        float rs[2][4];
#pragma unroll
        for (int ai = 0; ai < 2; ++ai)
#pragma unroll
            for (int m = 0; m < 4; ++m) rs[ai][m] = __builtin_amdgcn_rsqf(__hip_atomic_load(ssq + row0 + ai * HALF + m * 16, __ATOMIC_RELAXED, __HIP_MEMORY_SCOPE_AGENT) * (1.f / 1024.f) + 1e-6f);
        f32x4 wv[2][2];
#pragma unroll
        for (int bj = 0; bj < 2; ++bj)
#pragma unroll
            for (int n = 0; n < 2; ++n) wv[bj][n] = *(const f32x4*)(nw + col0 + bj * HALF + n * 4);
#pragma unroll
        for (int ai = 0; ai < 2; ++ai)
#pragma unroll
            for (int m = 0; m < 4; ++m) { const size_t off = (size_t)(row0 + ai * HALF + m * 16) * 1024 + col0;
#pragma unroll
                for (int bj = 0; bj < 2; ++bj)
#pragma unroll
                    for (int n = 0; n < 2; ++n) *(f32x4*)(out + off + bj * HALF + n * 4) = acc[ai][bj][m][n] * rs[ai][m] * wv[bj][n]; }
    }
};
struct InProjOrder {
    int G, c;
    __device__ __forceinline__ bool next(int i, Unit& u) const {
        constexpr int nM = 128, nN = 23, nwg = nM * nN;
        const long L = (long)i * G + c;
        if (L < nwg) {
            int wgid = (int)L; { const int q = nwg / NXCD, r = nwg % NXCD, xcd = wgid % NXCD, off = wgid / NXCD; wgid = (xcd < r ? xcd * (q + 1) : r * (q + 1) + (xcd - r) * q) + off; }
            const int nig = WGM * nN, gid = wgid / nig, fm = gid * WGM, gsz = (nM - fm) < WGM ? (nM - fm) : WGM;
            u.pm = fm + ((wgid % nig) % gsz); u.pn = (wgid % nig) / gsz; return true;
        }
        const int idx = (int)(L - nwg); if (idx >= 112) return false;
        const int j = idx >> 3; u.pm = 128 + (idx & 7); u.pn = j < 5 ? j : (j < 13 ? 9 + j : 22); return true;
    }
    __device__ __forceinline__ void a_ready(const Unit&) const {}
    __device__ __forceinline__ void done(const Unit&) const {}
};
template <class Epi, class Sched, bool ALIGN_EPI = false, bool SP2 = false>
__device__ __forceinline__ void gemm_phase(PG8_LAS unsigned char* lds, const Gemm g, const Sched& S, const Epi& E) {
    const int tid = threadIdx.x, wid = __builtin_amdgcn_readfirstlane(tid >> 6), lane = tid & 63, wr = wid >> 2, wc = wid & 3, fr = lane & 15, fq = lane >> 4;
    const int K = g.K, nt = K / BK;
    unsigned voffA[2], voffB[2];
#pragma unroll
    for (int i = 0; i < 2; ++i) { int R, C; stage_rc(tid * 16 + i * 8192, R, C); const int Rb = Epi::PERM ? ((R & ~31) + perm32(R & 31)) : R;
        voffA[i] = (unsigned)(R * K + C) * 2u; voffB[i] = (unsigned)(Rb * K + C) * 2u; }
    const size_t kstep = (size_t)(BK * 2);
    const size_t hstep = (size_t)HALF * K * 2;
    const size_t tstep = 2 * hstep;
    const unsigned ldsw = (unsigned)wid * 1024u;
    const int aoff = lds_byte(wr * 64 + fr, fq * 8), boff = lds_byte(wc * 32 + fr, fq * 8);
#define PG8_SA(b, h) (((b) * 2 + (h)) * HTB)
#define PG8_SB(b, h) ((4 + (b) * 2 + (h)) * HTB)
#define PG8_STAGE(bufoff, gbase, voff) do { _Pragma("unroll") for (int _i = 0; _i < 2; ++_i) \
        __builtin_amdgcn_global_load_lds((const unsigned*)((const char*)(gbase) + (voff)[_i]), (PG8_LAS unsigned*)(lds + (bufoff) + ldsw + _i * 8192), 16, 0, 0); } while (0)
#define PG8_LDA(dst, b, h) do { _Pragma("unroll") for (int m = 0; m < 4; ++m) _Pragma("unroll") for (int k = 0; k < 2; ++k) dst[m][k] = *(const PG8_LAS bf16x8*)(lds + PG8_SA(b, h) + aoff + m * 2048 + k * 1024); } while (0)
#define PG8_LDB(dst, b, h) do { _Pragma("unroll") for (int n = 0; n < 2; ++n) _Pragma("unroll") for (int k = 0; k < 2; ++k) dst[n][k] = *(const PG8_LAS bf16x8*)(lds + PG8_SB(b, h) + boff + n * 2048 + k * 1024); } while (0)
#define PG8_MMA(ai, bj, At, Bt) do { __builtin_amdgcn_s_setprio(1); _Pragma("unroll") for (int m = 0; m < 4; ++m) _Pragma("unroll") for (int n = 0; n < 2; ++n) _Pragma("unroll") for (int k = 0; k < 2; ++k) \
        acc[ai][bj][m][n] = __builtin_amdgcn_mfma_f32_16x16x32_bf16(Bt[n][k], At[m][k], acc[ai][bj][m][n], 0, 0, 0); __builtin_amdgcn_s_setprio(0); } while (0)
#define PG8_WAIT_V(n) asm volatile("s_waitcnt vmcnt(" #n ")" ::: "memory")
#define PG8_WAIT_L(n) asm volatile("s_waitcnt lgkmcnt(" #n ")" ::: "memory")
#define PG8_BAR __builtin_amdgcn_s_barrier()
#define PG8_SCHED __builtin_amdgcn_sched_barrier(0)
    Unit cur, nxt; int ui = 0;
    if (!S.next(0, cur)) return;
    f32x4 acc[2][2][4][2];
#pragma unroll
    for (int a = 0; a < 2; ++a)
#pragma unroll
        for (int b = 0; b < 2; ++b)
#pragma unroll
            for (int m = 0; m < 4; ++m)
#pragma unroll
                for (int n = 0; n < 2; ++n) acc[a][b][m][n] = (f32x4){0.f, 0.f, 0.f, 0.f};
    bf16x8 At[4][2], B0[2][2], B1[2][2];
    const char* cA = (const char*)g.A + (size_t)cur.pm * tstep; const char* cB = (const char*)g.Bt + (size_t)cur.pn * tstep;
    S.a_ready(cur);
    typename Epi::Pre epre; E.pre(epre, cur, wr, wc, fr, fq);
    if constexpr (SP2) {
        PG8_STAGE(PG8_SB(0, 0), cB, voffB); PG8_STAGE(PG8_SB(0, 1), cB + hstep, voffB); PG8_STAGE(PG8_SA(0, 0), cA, voffA); PG8_STAGE(PG8_SA(0, 1), cA + hstep, voffA);
        if (wr == 1) PG8_BAR;
        PG8_WAIT_V(2); PG8_BAR;
        PG8_STAGE(PG8_SB(1, 0), cB + kstep, voffB); PG8_STAGE(PG8_SA(1, 0), cA + kstep, voffA); PG8_STAGE(PG8_SB(1, 1), cB + hstep + kstep, voffB);
        PG8_WAIT_V(6); PG8_BAR;
    } else {
        PG8_STAGE(PG8_SB(0, 0), cB, voffB); PG8_STAGE(PG8_SA(0, 0), cA, voffA); PG8_STAGE(PG8_SB(0, 1), cB + hstep, voffB); PG8_STAGE(PG8_SA(0, 1), cA + hstep, voffA);
        if (wr == 1) PG8_BAR;
        PG8_WAIT_V(4); PG8_BAR;
        PG8_STAGE(PG8_SB(1, 0), cB + kstep, voffB); PG8_STAGE(PG8_SA(1, 0), cA + kstep, voffA); PG8_STAGE(PG8_SB(1, 1), cB + hstep + kstep, voffB);
        PG8_WAIT_V(6); PG8_BAR;
    }
    for (;;) {
        const bool has_next = S.next(ui + 1, nxt);
        const char* nA = has_next ? (const char*)g.A + (size_t)nxt.pm * tstep : cA; const char* nB = has_next ? (const char*)g.Bt + (size_t)nxt.pn * tstep : cB;
        for (int t = 0; t < nt; t += 2) {
            const bool last = (t == nt - 2);
            const char* a1 = cA + (size_t)(t + 1) * kstep;
            const char* a2 = last ? nA : cA + (size_t)(t + 2) * kstep; const char* b2 = last ? nB : cB + (size_t)(t + 2) * kstep;
            const char* a3 = a2 + kstep; const char* b3 = b2 + kstep;
            if (last && has_next) S.a_ready(nxt);
            if constexpr (SP2) {
            PG8_LDB(B0, 0, 0); PG8_LDB(B1, 0, 1); PG8_SCHED; PG8_LDA(At, 0, 0); PG8_STAGE(PG8_SA(1, 1), a1 + hstep, voffA);
            PG8_WAIT_V(8); PG8_WAIT_L(0); PG8_BAR; PG8_MMA(0, 0, At, B0); PG8_MMA(0, 1, At, B1); PG8_BAR; PG8_SCHED;
            PG8_LDA(At, 0, 1); PG8_STAGE(PG8_SB(0, 0), b2, voffB); PG8_STAGE(PG8_SB(0, 1), b2 + hstep, voffB); PG8_STAGE(PG8_SA(0, 0), a2, voffA);
            PG8_WAIT_V(8); PG8_WAIT_L(0); PG8_BAR; PG8_MMA(1, 0, At, B0); PG8_MMA(1, 1, At, B1); PG8_BAR; PG8_SCHED;
            PG8_LDB(B0, 1, 0); PG8_LDB(B1, 1, 1); PG8_SCHED; PG8_LDA(At, 1, 0); PG8_STAGE(PG8_SA(0, 1), a2 + hstep, voffA);
            PG8_WAIT_V(8); PG8_WAIT_L(0); PG8_BAR; PG8_MMA(0, 0, At, B0); PG8_MMA(0, 1, At, B1); PG8_BAR; PG8_SCHED;
            PG8_LDA(At, 1, 1); PG8_STAGE(PG8_SB(1, 0), b3, voffB); PG8_STAGE(PG8_SB(1, 1), b3 + hstep, voffB); PG8_STAGE(PG8_SA(1, 0), a3, voffA);
            PG8_WAIT_V(8); PG8_WAIT_L(0); PG8_BAR; PG8_MMA(1, 0, At, B0); PG8_MMA(1, 1, At, B1); PG8_BAR; PG8_SCHED;
            } else {
            PG8_LDB(B0, 0, 0); PG8_SCHED; PG8_LDA(At, 0, 0); PG8_STAGE(PG8_SA(1, 1), a1 + hstep, voffA);
            PG8_WAIT_L(8); PG8_BAR; PG8_WAIT_L(0); PG8_MMA(0, 0, At, B0); PG8_BAR; PG8_SCHED;
            PG8_LDB(B1, 0, 1); PG8_STAGE(PG8_SB(0, 0), b2, voffB);
            PG8_BAR; PG8_WAIT_L(0); PG8_MMA(0, 1, At, B1); PG8_BAR;
            PG8_LDA(At, 0, 1); PG8_STAGE(PG8_SA(0, 0), a2, voffA);
            PG8_BAR; PG8_WAIT_L(0); PG8_MMA(1, 0, At, B0); PG8_BAR; PG8_SCHED;
            PG8_STAGE(PG8_SB(0, 1), b2 + hstep, voffB);
            PG8_WAIT_V(6); PG8_BAR; PG8_MMA(1, 1, At, B1); PG8_BAR;
            PG8_LDB(B0, 1, 0); PG8_SCHED; PG8_LDA(At, 1, 0); PG8_STAGE(PG8_SA(0, 1), a2 + hstep, voffA);
            PG8_WAIT_L(8); PG8_BAR; PG8_WAIT_L(0); PG8_MMA(0, 0, At, B0); PG8_BAR; PG8_SCHED;
            PG8_LDB(B1, 1, 1); PG8_STAGE(PG8_SB(1, 0), b3, voffB);
            PG8_BAR; PG8_WAIT_L(0); PG8_MMA(0, 1, At, B1); PG8_BAR;
            PG8_LDA(At, 1, 1); PG8_STAGE(PG8_SA(1, 0), a3, voffA);
            PG8_BAR; PG8_WAIT_L(0); PG8_MMA(1, 0, At, B0); PG8_BAR; PG8_SCHED;
            PG8_STAGE(PG8_SB(1, 1), b3 + hstep, voffB);
            PG8_WAIT_V(6); PG8_BAR; PG8_MMA(1, 1, At, B1); PG8_BAR;
            }
        }
        if constexpr (ALIGN_EPI) { if (wr == 0) PG8_BAR; }
        if constexpr (!Epi::AFTER_DRAIN) { E(acc, cur, wr, wc, fr, fq, epre); S.done(cur); }
        if (!has_next) break;
#pragma unroll
        for (int a = 0; a < 2; ++a)
#pragma unroll
            for (int b = 0; b < 2; ++b)
#pragma unroll
                for (int m = 0; m < 4; ++m)
#pragma unroll
                    for (int n = 0; n < 2; ++n) acc[a][b][m][n] = (f32x4){0.f, 0.f, 0.f, 0.f};
        cur = nxt; cA = nA; cB = nB; ++ui; E.pre(epre, cur, wr, wc, fr, fq);
        if constexpr (ALIGN_EPI) { if (wr == 1) PG8_BAR; }
    }
    PG8_WAIT_V(0);
    if constexpr (!ALIGN_EPI) { if (wr == 0) PG8_BAR; }
    PG8_BAR;
    if constexpr (Epi::AFTER_DRAIN) { E.fused(acc, cur, wr, wc, fr, fq, lds, wid, lane); S.done(cur); }
#undef PG8_SA
#undef PG8_SB
#undef PG8_STAGE
#undef PG8_LDA
#undef PG8_LDB
#undef PG8_MMA
#undef PG8_WAIT_V
#undef PG8_WAIT_L
#undef PG8_BAR
#undef PG8_SCHED
}
}
#define GAS __attribute__((address_space(1)))
#define LAS __attribute__((address_space(3)))
typedef unsigned short bf16;
typedef unsigned v4u __attribute__((ext_vector_type(4)));
typedef float f32x4 __attribute__((ext_vector_type(4)));
typedef short bf16x8 __attribute__((ext_vector_type(8)));
typedef GAS unsigned gu32;
typedef GAS unsigned long long gu64;
#define RLX_AGENT __ATOMIC_RELAXED, __HIP_MEMORY_SCOPE_AGENT
#define LDS_WAIT() asm volatile("s_waitcnt lgkmcnt(0)" ::: "memory")
#define VM_WAIT() asm volatile("s_waitcnt vmcnt(0)" ::: "memory")
__device__ __forceinline__ unsigned long long rt() { return __builtin_amdgcn_s_memrealtime(); }
__device__ __forceinline__ unsigned f2bf(float f) { unsigned u = __builtin_bit_cast(unsigned, f); return (u + 0x7fffu + ((u >> 16) & 1u)) >> 16; }
__device__ __forceinline__ unsigned pk2(float lo, float hi) { return f2bf(lo) | (f2bf(hi) << 16); }

__device__ __forceinline__ float wave_sum(float v) {
#pragma unroll
    for (int o = 1; o < 64; o <<= 1) v += __shfl_xor(v, o);
    return v;
}
#define XB_TMO      128
#define XB_XCNT(j)  (256  + 64 * (j))
#define XB_XSUB(j)  (1280 + 64 * (j))
#define XB_XGEN(j)  (2304 + 64 * (j))
#define XB_TOP      3328
#define XB_TOPGEN   3392
#define XCD_BAR_WORDS 3456
#define XB_SPIN_CAP (1u << 18)

__device__ __forceinline__ unsigned xb_ld(unsigned* p)              { return __hip_atomic_load(p, __ATOMIC_RELAXED, __HIP_MEMORY_SCOPE_AGENT); }
__device__ __forceinline__ unsigned xb_add(unsigned* p, unsigned v) { return __hip_atomic_fetch_add(p, v, __ATOMIC_RELAXED, __HIP_MEMORY_SCOPE_AGENT); }
__device__ __forceinline__ unsigned xb_xcc_id() { return (unsigned)__builtin_amdgcn_s_getreg((3 << 11) | 20) & 0xFu; }
#define XB_SPIN(cond, bar) do { unsigned _sp = 0; while (cond) { __builtin_amdgcn_s_sleep(1); \
    if ((++_sp & 255u) == 0u) { if (xb_ld(&(bar)[XB_TMO])) break; if (_sp > XB_SPIN_CAP) { atomicAdd(&(bar)[XB_TMO], 1u); break; } } } } while (0)

struct XcdBarrier {
    unsigned* bar; unsigned x;
    volatile LAS unsigned* st;
};

__device__ __forceinline__ XcdBarrier xcd_barrier_post(unsigned* bar, volatile LAS unsigned* st) {
    XcdBarrier b; b.bar = bar; b.x = xb_xcc_id(); b.st = st;
    if (threadIdx.x == 0) (void)xb_add(&bar[XB_XCNT(b.x)], 1u);
    return b;
}
__device__ __forceinline__ void xcd_barrier_complete(unsigned* bar, unsigned x, unsigned& nloc, unsigned& nx) {
    const unsigned G = gridDim.x * gridDim.y * gridDim.z;
    unsigned sum, cnt, mine, sp = 0u;
    for (;;) {
        sum = 0u; cnt = 0u; mine = 0u;
#pragma unroll
        for (unsigned j = 0; j < 16; ++j) { const unsigned c = xb_ld(&bar[XB_XCNT(j)]); sum += c; cnt += (c > 0u) ? 1u : 0u; mine = (j == x) ? c : mine; }
        if (sum == G) break;
        __builtin_amdgcn_s_sleep(1);
        if ((++sp & 255u) == 0u) { if (xb_ld(&bar[XB_TMO])) break; if (sp > XB_SPIN_CAP) { atomicAdd(&bar[XB_TMO], 1u); break; } }
    }
    nloc = mine > 0u ? mine : 1u; nx = cnt > 0u ? cnt : 1u;
}

__device__ __forceinline__ void xcd_barrier(const XcdBarrier& b) {
    asm volatile("s_waitcnt vmcnt(0)" ::: "memory");
    __syncthreads();
    if (threadIdx.x == 0) {
        unsigned* bar = b.bar;
        __builtin_amdgcn_s_waitcnt(0);
        unsigned nloc = b.st[0], nx = b.st[1];
        if (nloc == 0u) { xcd_barrier_complete(bar, b.x, nloc, nx); b.st[0] = nloc; b.st[1] = nx; }
        const unsigned old = xb_add(&bar[XB_XSUB(b.x)], 1u);
        const unsigned gen = old / nloc;
        if (old + 1u == (gen + 1u) * nloc) {
            __builtin_amdgcn_fence(__ATOMIC_RELEASE, "agent");
            asm volatile("s_waitcnt vmcnt(0)" ::: "memory");
            const unsigned og = xb_add(&bar[XB_TOP], 1u);
            const unsigned tg = og / nx;
            __builtin_amdgcn_fence(__ATOMIC_ACQUIRE, "agent");
            if (og + 1u == (tg + 1u) * nx) xb_add(&bar[XB_TOPGEN], 1u);
            else XB_SPIN(xb_ld(&bar[XB_TOPGEN]) == tg, bar);
            xb_add(&bar[XB_XGEN(b.x)], 1u);
            asm volatile("s_waitcnt vmcnt(0)" ::: "memory");
        } else {
            __builtin_amdgcn_fence(__ATOMIC_ACQUIRE, "agent");
            XB_SPIN(xb_ld(&bar[XB_XGEN(b.x)]) == gen, bar);
            asm volatile("s_waitcnt vmcnt(0)" ::: "memory");
        }
    }
    __syncthreads();
}
namespace cg = cooperative_groups;
constexpr int NWAVES = 8, NTHR = 512;
constexpr int D = 1024, BATCH = 8, SEQ = 4096, CTXL = 256, M_LAT = BATCH * SEQ, M_CTX = BATCH * CTXL, M_ALL = M_LAT + M_CTX;
constexpr int DFF = 4096, NIN0 = 5888;
constexpr int OFF_X = 0, OFF_B = 1024, OFF_DT = 1280, OFF_K = 1312, OFF_V = 2336, OFF_C = 3360, OFF_Z = 3616, OFF_Q = 4640, IN0 = 5664;
constexpr int NCH = 34;
constexpr float RMS_EPS = 1e-6f, LOG2E = 1.4426950408889634f;
constexpr size_t MiB = 1u << 20;
constexpr size_t WS_CTL = 0, CTL_ZERO_BYTES = 1024 * 1024;
constexpr size_t WS_SSQ = 64 * 1024, WS_BIASB = 576 * 1024;
constexpr size_t WS_TICKET = 32 * 1024;
constexpr size_t WS_PCNT = 960 * 1024;
constexpr size_t WS_WSV = 1 * MiB + 768 * 1024;
constexpr size_t WS_MOD = 1 * MiB, WS_MODCTX = 1 * MiB + 512 * 1024;
constexpr size_t WS_WIN = 2 * MiB, WS_WOUT = 14 * MiB;
constexpr size_t WS_H = 18 * MiB;
constexpr size_t WS_XBC = 86 * MiB;
constexpr size_t WS_ZQ = 188 * MiB;
constexpr size_t WS_KV = 316 * MiB;
constexpr size_t WS_DTRAW = 452 * MiB;
constexpr size_t WS_BC = 457 * MiB, WS_CC = 474 * MiB;
constexpr size_t WS_LA = 490 * MiB, WS_LD = 495 * MiB, WS_ATOT = 500 * MiB;
constexpr size_t WS_END = 504 * MiB;
constexpr size_t WS_XB = 124 * MiB;
constexpr size_t WS_YTMP = 124 * MiB;
constexpr size_t WS_W1T0 = 86 * MiB, WS_W2T0 = 94 * MiB, WS_W1T1 = 102 * MiB, WS_W2T1 = 110 * MiB, WS_SCIN = 118 * MiB, WS_SCOUT = 502 * MiB;
constexpr size_t WS_YF = 316 * MiB, WS_YB = 380 * MiB;
constexpr size_t WS_HID = 188 * MiB;
constexpr size_t WS_P1 = 188 * MiB, WS_G1 = 380 * MiB;
constexpr int RING_BYTES = 131072, LDSCTL_OFF = RING_BYTES, MISC_OFF = LDSCTL_OFF + 320, LDS_BYTES = 147456;

typedef short s16x4 __attribute__((ext_vector_type(4)));
typedef float f32x16 __attribute__((ext_vector_type(16)));
typedef float f32x2 __attribute__((ext_vector_type(2)));
typedef __bf16 bf16x2_t __attribute__((ext_vector_type(2)));
typedef LAS unsigned char* lptr;
__device__ __forceinline__ unsigned cvtpk(float lo, float hi) { f32x2 v = {lo, hi}; bf16x2_t b = __builtin_convertvector(v, bf16x2_t); return __builtin_bit_cast(unsigned, b); }
__device__ __forceinline__ float bflo(unsigned u) { return __uint_as_float(u << 16); }
__device__ __forceinline__ float bfhi(unsigned u) { return __uint_as_float(u & 0xffff0000u); }
__device__ __forceinline__ float silu_f(float v) { return v * __builtin_amdgcn_rcpf(1.f + __expf(-v)); }
__device__ __forceinline__ float softplus_f(float v) {
    const float x = __expf(-fabsf(v)); const float lp = x < 0.015625f ? x * (1.f + x * (-0.5f + x * (0.33333334f - 0.25f * x))) : __logf(1.f + x); return fmaxf(v, 0.f) + lp; }
__device__ __forceinline__ int crow(int r, int hi) { return (r & 3) + 8 * (r >> 2) + 4 * hi; }
__device__ __forceinline__ int clampi(int v, int lo, int hi) { return v < lo ? lo : (v > hi ? hi : v); }
__device__ __forceinline__ s16x4 trd(lptr p) { typedef short v4i16_t __attribute__((ext_vector_type(4))); return __builtin_bit_cast(s16x4, __builtin_amdgcn_ds_read_tr16_b64_v4i16((LAS v4i16_t*)p)); }
__device__ __forceinline__ bf16x8 cat8(s16x4 a, s16x4 b) { return (bf16x8){a[0], a[1], a[2], a[3], b[0], b[1], b[2], b[3]}; }
#define MFMA32(a, b, c) __builtin_amdgcn_mfma_f32_32x32x16_bf16((a), (b), (c), 0, 0, 0)
__device__ __forceinline__ unsigned off_b(unsigned row, unsigned ch) { return 256u * row + 16u * (ch ^ (((row & 3) << 2) | ((row >> 2) & 3))); }

#define WG_BAR() do { asm volatile("s_waitcnt lgkmcnt(0)" ::: "memory"); __builtin_amdgcn_s_barrier(); asm volatile("" ::: "memory"); } while (0)
__device__ __forceinline__ void glds16(const void* gsrc, unsigned lds_dst) { unsigned keep;
    asm volatile("s_mov_b32 %0, m0\n\ts_mov_b32 m0, %2\n\ts_nop 0\n\tglobal_load_lds_dwordx4 %1, off\n\ts_mov_b32 m0, %0" : "=&s"(keep) : "v"(gsrc), "s"(lds_dst) : "memory"); }
__device__ __forceinline__ void stwt16(void* p, v4u v) { asm volatile("global_store_dwordx4 %0, %1, off sc1\n\ts_nop 1" :: "v"(p), "v"(v) : "memory"); }
__device__ __forceinline__ void stwt8(void* p, unsigned long long v) { asm volatile("global_store_dwordx2 %0, %1, off sc1\n\ts_nop 0" :: "v"(p), "v"(v) : "memory"); }
struct Args {
    const float* in[23]; float* out; unsigned char* ws; int ph_lo, ph_hi, use_cg, pad;
};

__device__ __forceinline__ void transpose_block(const float* W, int ldw, int K, bf16* WT, int dst_row0, int src_col0, int kb, LAS float* scr, int lane) {
    const int k0 = 64 * kb;
    f32x4 v[8];
#pragma unroll
    for (int i = 0; i < 8; ++i) v[i] = __builtin_nontemporal_load((const GAS f32x4*)(W + (size_t)(k0 + (lane >> 3) + 8 * i) * ldw + src_col0 + 4 * (lane & 7)));
#pragma unroll
    for (int i = 0; i < 8; ++i) { LAS float* d = scr + ((lane >> 3) + 8 * i) * 33 + 4 * (lane & 7); d[0] = v[i].x; d[1] = v[i].y; d[2] = v[i].z; d[3] = v[i].w; }
    LDS_WAIT(); asm volatile("" ::: "memory");
    const int c = lane & 7;
#pragma unroll
    for (int j = 0; j < 4; ++j) { const int n = (lane >> 3) + 8 * j; const LAS float* s = scr + (8 * c) * 33 + n;
        v4u o; o.x = cvtpk(s[0 * 33], s[1 * 33]); o.y = cvtpk(s[2 * 33], s[3 * 33]); o.z = cvtpk(s[4 * 33], s[5 * 33]); o.w = cvtpk(s[6 * 33], s[7 * 33]);
        *(GAS v4u*)(WT + (size_t)(dst_row0 + n) * K + k0 + 8 * c) = o; }
    LDS_WAIT(); asm volatile("" ::: "memory");
}
__device__ __forceinline__ void transpose_plain(const float* W, int K, int N, bf16* WT, int item, LAS float* scr, int lane) {
    const int nblk = N / 32, kb = item / nblk, nb = item % nblk;
    transpose_block(W, N, K, WT, 32 * nb, 32 * nb, kb, scr, lane);
}
template <bool REMAP>
__device__ __forceinline__ void transpose_bias_t(const float* W, int K, int N, bf16* WT, int item, LAS float* scr, int lane, const float* shift, float* bias, int bstride) {
    const int nblk = N / 32, kb = item / nblk, nb = item % nblk, k0 = 64 * kb;
    int srcc = 32 * nb; if (REMAP && srcc >= 1024) { const int t = (srcc - 1024) >> 8, wv_ = (srcc - 1024) & 255; srcc = wv_ < 128 ? 1024 + 128 * t + wv_ : 2048 + 128 * t + wv_ - 128; }
    LAS float* sh = scr + 64 * 33 + 16;
#pragma unroll
    for (int i = 0; i < 8; ++i) sh[i * 64 + lane] = shift[(size_t)i * 6144 + k0 + lane];
    f32x4 v[8];
#pragma unroll
    for (int i = 0; i < 8; ++i) v[i] = __builtin_nontemporal_load((const GAS f32x4*)(W + (size_t)(k0 + (lane >> 3) + 8 * i) * N + srcc + 4 * (lane & 7)));
#pragma unroll
    for (int i = 0; i < 8; ++i) { LAS float* d = scr + ((lane >> 3) + 8 * i) * 33 + 4 * (lane & 7); d[0] = v[i].x; d[1] = v[i].y; d[2] = v[i].z; d[3] = v[i].w; }
    LDS_WAIT(); asm volatile("" ::: "memory");
    { const int n = lane & 31, b0 = 4 * (lane >> 5); float acc4[4] = {0.f, 0.f, 0.f, 0.f};
      for (int kk = 0; kk < 64; ++kk) { const float wv = scr[kk * 33 + n];
#pragma unroll
          for (int q = 0; q < 4; ++q) acc4[q] += sh[(b0 + q) * 64 + kk] * wv; }
#pragma unroll
      for (int q = 0; q < 4; ++q) atomicAdd(bias + (size_t)(b0 + q) * bstride + 32 * nb + n, acc4[q]); }
    const int c = lane & 7;
#pragma unroll
    for (int j = 0; j < 4; ++j) { const int n = (lane >> 3) + 8 * j; const LAS float* s = scr + (8 * c) * 33 + n;
        v4u o; o.x = cvtpk(s[0 * 33], s[1 * 33]); o.y = cvtpk(s[2 * 33], s[3 * 33]); o.z = cvtpk(s[4 * 33], s[5 * 33]); o.w = cvtpk(s[6 * 33], s[7 * 33]);
        *(GAS v4u*)(WT + (size_t)(32 * nb + n) * K + k0 + 8 * c) = o; }
    LDS_WAIT(); asm volatile("" ::: "memory");
}
__device__ __forceinline__ void transpose_plain_bias(const float* W, int K, int N, bf16* WT, int item, LAS float* scr, int lane, const float* shift, float* bias, int bstride) { transpose_bias_t<false>(W, K, N, WT, item, scr, lane, shift, bias, bstride); }
__device__ __forceinline__ void transpose_remap_bias(const float* W, int K, int N, bf16* WT, int item, LAS float* scr, int lane, const float* shift, float* bias, int bstride) { transpose_bias_t<true>(W, K, N, WT, item, scr, lane, shift, bias, bstride); }
__device__ __forceinline__ int in0_src_col(int dst) {
    if (dst < 1024) return OFF_X + dst;
    if (dst < 1280) return OFF_B + dst - 1024;
    if (dst < 1536) return OFF_C + dst - 1280;
    if (dst < 2560) return OFF_Z + dst - 1536;
    if (dst < 3584) return OFF_Q + dst - 2560;
    if (dst < 4608) return OFF_K + dst - 3584;
    if (dst < 5632) return OFF_V + dst - 4608;
    return OFF_DT + dst - 5632;
}
__device__ __forceinline__ void p0_prologue(const Args& A, lptr lds, int tid, int vcu, int G) {
    unsigned char* ws = A.ws;
    {
        const int task = blockIdx.x % 256, layer = task >> 7, n0 = (task & 127) * 48;
        LAS float* sc = (LAS float*)lds;
        LAS float* red = (LAS float*)(lds + 9 * 4096);
        const int c4 = tid & 15, kp = tid >> 4, wave = tid >> 6; const bool act = c4 < 12;
        const float* wp = A.in[4] + (size_t)layer * D * 6 * D + n0 + 4 * (act ? c4 : 0) + (size_t)(kp * 32) * 6 * D;
        f32x4 wv[32];
#pragma unroll
        for (int q = 0; q < 16; ++q) wv[q] = __builtin_nontemporal_load((const GAS f32x4*)(wp + (size_t)q * 6 * D));
#pragma unroll 6
        for (int i = tid; i < 9 * 1024; i += NTHR) { const float v = i < 8192 ? A.in[1][i] : A.in[3][i - 8192]; sc[i] = silu_f(v); }
#pragma unroll
        for (int q = 16; q < 32; ++q) wv[q] = __builtin_nontemporal_load((const GAS f32x4*)(wp + (size_t)q * 6 * D));
        __syncthreads();
        f32x4 acc[9];
#pragma unroll
        for (int bb = 0; bb < 9; ++bb) acc[bb] = (f32x4){0.f, 0.f, 0.f, 0.f};
#pragma unroll
        for (int q4 = 0; q4 < 8; ++q4) { asm volatile("" ::: "memory"); __builtin_amdgcn_sched_barrier(0);
#pragma unroll
            for (int bb = 0; bb < 9; ++bb) { const f32x4 s = *(const LAS f32x4*)(sc + bb * 1024 + kp * 32 + 4 * q4);
                acc[bb] += wv[4 * q4] * s.x; acc[bb] += wv[4 * q4 + 1] * s.y; acc[bb] += wv[4 * q4 + 2] * s.z; acc[bb] += wv[4 * q4 + 3] * s.w;
                asm volatile("" : "+v"(acc[bb])); } }
#pragma unroll
        for (int bb = 0; bb < 9; ++bb) {
#pragma unroll
            for (int e = 0; e < 4; ++e) { float v = acc[bb][e]; v += __shfl_xor(v, 16); v += __shfl_xor(v, 32); acc[bb][e] = v; }
            if ((tid & 63) < 12) *(LAS f32x4*)(red + (wave * 9 + bb) * 64 + 4 * c4) = acc[bb]; }
        __syncthreads();
        float* MOD = (float*)(ws + WS_MOD); float* MODCTX = (float*)(ws + WS_MODCTX);
        for (int i = tid; i < 9 * 64; i += NTHR) { const int bb = i >> 6, cc = i & 63; if (cc >= 48) continue; float s = A.in[5][layer * 6 * D + n0 + cc];
#pragma unroll
            for (int q = 0; q < 8; ++q) s += red[(q * 9 + bb) * 64 + cc];
            if (bb < 8) MOD[(size_t)(layer * 8 + bb) * 6 * D + n0 + cc] = s; else if (layer == 0 && n0 + cc < 2 * D) MODCTX[n0 + cc] = s; }
        __syncthreads();
    }
}
__device__ __forceinline__ void early_weights(const Args& A, lptr lds, int tid, int vcu, int G) {
    const int lane = tid & 63, wave = tid >> 6;
    unsigned char* ws = A.ws;
    LAS float* scr = (LAS float*)(lds + wave * 16384);
    const int gw = vcu * NWAVES + wave, NGW = G * NWAVES;
    bf16* WIN = (bf16*)(ws + WS_WIN); bf16* WOUT = (bf16*)(ws + WS_WOUT);
    constexpr int I_IN = (IN0 / 32) * (D / 64), I_OUT = (D / 32) * (2 * D / 64);
    for (int it = gw; it < I_IN + I_OUT; it += NGW) {
        if (it < I_IN) { const int nb = it % (IN0 / 32), kb = it / (IN0 / 32); transpose_block(A.in[10], IN0, D, WIN, 32 * nb, in0_src_col(32 * nb), kb, scr, lane); }
        else transpose_plain(A.in[18], 2 * D, D, WOUT, it - I_IN, scr, lane);
    }
    { const int gt = vcu * NTHR + tid, NGT = G * NTHR; v4u z = {0u, 0u, 0u, 0u};
      for (int i = gt; i < 224 * 128; i += NGT) *(GAS v4u*)((unsigned char*)WIN + (size_t)IN0 * 2048 + (size_t)i * 16) = z; }
}
__device__ __forceinline__ void late_item(const Args& A, int r, LAS float* scr, int lane) {
    unsigned char* ws = A.ws;
    constexpr int I_1 = (DFF / 32) * (D / 64), I_2 = (D / 32) * (DFF / 64), I_SI = (3 * D / 32) * (D / 64);
    const float* MODp = (const float*)(ws + WS_MOD); float* BIASB = (float*)(ws + WS_BIASB);
    if (r < I_1) { transpose_plain_bias(A.in[8], D, DFF, (bf16*)(ws + WS_W1T0), r, scr, lane, MODp + 3 * D, BIASB, 4096); return; } r -= I_1;
    if (r < I_1) { transpose_plain_bias(A.in[8] + (size_t)D * DFF, D, DFF, (bf16*)(ws + WS_W1T1), r, scr, lane, MODp + (size_t)8 * 6 * D + 3 * D, BIASB + 2 * 8 * 4096, 4096); return; } r -= I_1;
    if (r < I_2) { transpose_plain(A.in[9], DFF, D, (bf16*)(ws + WS_W2T0), r, scr, lane); return; } r -= I_2;
    if (r < I_2) { transpose_plain(A.in[9] + (size_t)DFF * D, DFF, D, (bf16*)(ws + WS_W2T1), r, scr, lane); return; } r -= I_2;
    if (r < I_SI) { transpose_remap_bias(A.in[19], D, 3 * D, (bf16*)(ws + WS_SCIN), r, scr, lane, MODp + (size_t)8 * 6 * D, BIASB + 1 * 8 * 4096, 4096); return; } r -= I_SI;
    transpose_plain(A.in[21], D, D, (bf16*)(ws + WS_SCOUT), r, scr, lane);
}
__device__ __forceinline__ void late_weights(const Args& A, lptr lds, int tid, int vcu, int G) {
    const int lane = tid & 63, wave = tid >> 6; unsigned char* ws = A.ws;
    LAS float* scr = (LAS float*)(lds + wave * 16384);
    constexpr int I_1 = (DFF / 32) * (D / 64), I_2 = (D / 32) * (DFF / 64), I_SI = (3 * D / 32) * (D / 64), I_SO = (D / 32) * (D / 64);
    constexpr int TOT = 2 * I_1 + 2 * I_2 + I_SI + I_SO;
    (void)vcu; (void)G;
    const int pq = blockIdx.x & 7; unsigned* tk = (unsigned*)(ws + WS_TICKET) + 64 * (8 + pq);
    unsigned tv = 0u; if (lane == 0) tv = __hip_atomic_fetch_add(tk, 1u, __ATOMIC_RELAXED, __HIP_MEMORY_SCOPE_AGENT);
#define LW_ITEM(t_) ((int)(((t_) >> 3) * 64u + 8u * (unsigned)pq + ((t_) & 7u)))
    int it = LW_ITEM(__builtin_amdgcn_readfirstlane(tv));
    while (it < TOT) {
        unsigned tn = 0u; if (lane == 0) tn = __hip_atomic_fetch_add(tk, 1u, __ATOMIC_RELAXED, __HIP_MEMORY_SCOPE_AGENT);
        late_item(A, it, scr, lane);
        it = LW_ITEM(__builtin_amdgcn_readfirstlane(tn));
    }
#undef LW_ITEM
}
__device__ __forceinline__ void norm_row_bf16(const float* xrow, const float* w, const float* shift, const float* scale, bf16* orow, int lane) {
    const GAS f32x4* xr = (const GAS f32x4*)xrow + 2 * lane;
    f32x4 v[4]; float s = 0.f;
#pragma unroll
    for (int j = 0; j < 2; ++j) { v[2 * j] = __builtin_nontemporal_load(xr + 128 * j); v[2 * j + 1] = __builtin_nontemporal_load(xr + 128 * j + 1);
        s += (v[2 * j].x * v[2 * j].x + v[2 * j].y * v[2 * j].y) + (v[2 * j].z * v[2 * j].z + v[2 * j].w * v[2 * j].w);
        s += (v[2 * j + 1].x * v[2 * j + 1].x + v[2 * j + 1].y * v[2 * j + 1].y) + (v[2 * j + 1].z * v[2 * j + 1].z + v[2 * j + 1].w * v[2 * j + 1].w); }
    const float rstd = rsqrtf(wave_sum(s) * (1.f / D) + RMS_EPS);
#pragma unroll
    for (int j = 0; j < 2; ++j) { const int c = 8 * lane + 512 * j; v4u o;
#pragma unroll
        for (int q = 0; q < 2; ++q) { const f32x4 wv = *(const f32x4*)(w + c + 4 * q), sh = *(const f32x4*)(shift + c + 4 * q), sc = *(const f32x4*)(scale + c + 4 * q);
            const f32x4 h = v[2 * j + q] * rstd * wv * (sc + 1.f) + sh;
            o[2 * q] = cvtpk(h.x, h.y); o[2 * q + 1] = cvtpk(h.z, h.w); }
        *(GAS v4u*)(orow + c) = o; }
}
__device__ __forceinline__ void norm_phase(const Args& A, const float* src, const float* w, int layer, int sel  , bool with_ctx, int tid, int vcu, int G) {
    const int lane = tid & 63, wave = tid >> 6, gw = vcu * NWAVES + wave, NGW = G * NWAVES;
    const float* MOD = (const float*)(A.ws + WS_MOD); const float* MODCTX = (const float*)(A.ws + WS_MODCTX);
    bf16* H = (bf16*)(A.ws + WS_H);
    const int nrows = with_ctx ? M_ALL : M_LAT;
    for (int r = gw; r < nrows; r += NGW) {
        if (r < M_LAT) { const float* mb = MOD + (size_t)(layer * 8 + (r >> 12)) * 6 * D + (sel ? 3 * D : 0);
            norm_row_bf16(src + (size_t)r * D, w, mb, mb + D, H + (size_t)r * D, lane); }
        else norm_row_bf16(A.in[2] + (size_t)(r - M_LAT) * D, w, MODCTX, MODCTX + D, H + (size_t)r * D, lane);
    }
}
__device__ __forceinline__ void wsv_phase(const Args& A, int tid) {
    const float* MOD = (const float*)(A.ws + WS_MOD); float* WSV = (float*)(A.ws + WS_WSV);
    for (int i = tid; i < 3 * 8 * 1024; i += NTHR) { const int site = i >> 13, b = (i >> 10) & 7, c = i & 1023;
        const float nw = site == 0 ? A.in[7][c] : (site == 1 ? A.in[6][D + c] : A.in[7][D + c]);
        const float sc = site == 0 ? MOD[(size_t)b * 6 * D + 4 * D + c] : (site == 1 ? MOD[(size_t)(8 + b) * 6 * D + 1 * D + c] : MOD[(size_t)(8 + b) * 6 * D + 4 * D + c]);
        WSV[i] = nw * (1.f + sc); }
}
__device__ __forceinline__ void final_norm_phase(const Args& A, int tid, int vcu, int G) {
    const int lane = tid & 63, wave = tid >> 6, gw = vcu * NWAVES + wave, NGW = G * NWAVES;
    const float* w = A.in[22];
    for (int r = gw; r < M_LAT; r += NGW) {
        GAS f32x4* xr = (GAS f32x4*)(A.out + (size_t)r * D) + lane;
        f32x4 v[4]; float s = 0.f;
#pragma unroll
        for (int j = 0; j < 4; ++j) { v[j] = xr[64 * j]; s += (v[j].x * v[j].x + v[j].y * v[j].y) + (v[j].z * v[j].z + v[j].w * v[j].w); }
        const float rstd = rsqrtf(wave_sum(s) * (1.f / D) + RMS_EPS);
#pragma unroll
        for (int j = 0; j < 4; ++j) xr[64 * j] = v[j] * rstd * *(const f32x4*)(w + 4 * lane + 256 * j);
    }
}
constexpr int NA_K0 = 0, NA_V0 = 32768, NA_TBL = 65536, NA_WSF = 65536 + 2560;
__device__ __forceinline__ unsigned kv_off(unsigned row, unsigned ch, unsigned sw) { return row * 128 + ((ch ^ sw) << 4); }
#define NA_TILE(baseA, baseB, WINDOW) do { \
    f32x16 p0, p1; \
    { const float ng = -m_run; _Pragma("unroll") for (int r = 0; r < 16; ++r) { p0[r] = ng; p1[r] = ng; } }     \
    if (PMODE != 5) { const unsigned rowA = (baseA) + r32, rowB = (baseB) + r32, swA = (rowA >> 1) & 7, swB = (rowB >> 1) & 7; \
      __builtin_amdgcn_s_setprio(1); \
      _Pragma("unroll") for (int s = 0; s < 4; ++s) { \
        const bf16x8 a0 = *(const LAS bf16x8*)(kb + kv_off(rowA, 2 * s + hi, swA)); \
        const bf16x8 a1 = *(const LAS bf16x8*)(kb + kv_off(rowB, 2 * s + hi, swB)); \
        p0 = MFMA32(a0, qf[s], p0); p1 = MFMA32(a1, qf[s], p1); } \
      __builtin_amdgcn_s_setprio(0); } \
    if (WINDOW && PMODE < 3) { \
        int clo = clo_; asm volatile("" : "+v"(clo)); \
        _Pragma("unroll") for (int r = 0; r < 16; ++r) { const int kcc = (r & 3) + 8 * (r >> 2); const bool cv = (unsigned)(kcc - clo) < 16u; \
            const float ba = tbA[kcc], bb = tbB[kcc]; const float sa = p0[r] + ba, sb = p1[r] + bb; \
            p0[r] = (cv && vA) ? sa : -1e30f; \
            p1[r] = (cv && vB) ? sb : -1e30f; } \
    } \
    if (PMODE < 3) { \
    float mt = __builtin_fmaxf(p0[0], p1[0]); \
    _Pragma("unroll") for (int r = 1; r < 16; ++r) mt = __builtin_fmaxf(__builtin_fmaxf(mt, p0[r]), p1[r]); \
    mt = fmaxf(mt, __shfl_xor(mt, 32)); \
    if (first_tile || __any(mt > 0.f)) { \
        const float dl = first_tile ? mt : fmaxf(mt, 0.f), alpha = __builtin_amdgcn_exp2f(-dl); \
        m_run += dl; l_run *= alpha; \
        _Pragma("unroll") for (int r = 0; r < 16; ++r) { p0[r] -= dl; p1[r] -= dl; } \
        if (hi == 0) wsf[r32] = alpha; \
        _Pragma("unroll") for (int g4 = 0; g4 < 4; ++g4) { const f32x4 aq = *(const LAS f32x4*)(wsf + 8 * g4 + 4 * hi); \
            _Pragma("unroll") for (int e = 0; e < 4; ++e) { o0[4 * g4 + e] *= aq[e]; o1[4 * g4 + e] *= aq[e]; } } \
        first_tile = false; \
    } \
    float rsum = 0.f; \
    _Pragma("unroll") for (int r = 0; r < 16; ++r) { p0[r] = __builtin_amdgcn_exp2f(p0[r]); p1[r] = __builtin_amdgcn_exp2f(p1[r]); rsum += p0[r] + p1[r]; } \
    l_run += rsum; } \
    __builtin_amdgcn_sched_barrier(0); \
    if (PMODE >= 4) { _Pragma("unroll") for (int r = 0; r < 16; ++r) { o0[r] += p0[r]; o1[r] += p1[r]; } } else { __builtin_amdgcn_s_setprio(1); \
    _Pragma("unroll") for (int k = 0; k < 4; ++k) { v4u u; \
        _Pragma("unroll") for (int jj = 0; jj < 4; ++jj) { const int rr = 8 * (k & 1) + 2 * jj; u[jj] = (k < 2) ? cvtpk(p0[rr], p0[rr + 1]) : cvtpk(p1[rr], p1[rr + 1]); } \
        const bf16x8 pak = __builtin_bit_cast(bf16x8, u); \
        const unsigned vrow = ((k < 2) ? (baseA) : (baseB)) + 16 * (k & 1); \
        { const s16x4 lo4 = trd(vb + voff0 + vrow * 128), hi4 = trd(vb + voff0 + (vrow + 8) * 128); o0 = MFMA32(pak, cat8(lo4, hi4), o0); } \
        { const s16x4 lo4 = trd(vb + voff1 + vrow * 128), hi4 = trd(vb + voff1 + (vrow + 8) * 128); o1 = MFMA32(pak, cat8(lo4, hi4), o1); } } \
    __builtin_amdgcn_s_setprio(0); } \
} while (0)
constexpr int NG_CK = 0, NG_CV = 32768, NG_RK = 65536, NG_RV = 98304, NG_TBL = 131072 + 1024, NG_WSF = NG_TBL + 2560;
template <int PMODE>
__device__ __forceinline__ void na_group(const Args& A, lptr lds, int b, int h, int band0, int tid, bf16* OUT) {
    const int lane = tid & 63, w = __builtin_amdgcn_readfirstlane(tid >> 6), r32 = lane & 31, hi = lane >> 5;
    const bf16* KV = (const bf16*)(A.ws + WS_KV); const bf16* ZQ = (const bf16*)(A.ws + WS_ZQ);
    const int rp = w >> 2, jb = w & 3, qcol = 16 * jb + (r32 & 15), kc0 = clampi(16 * jb - 8, 0, 32);
    LAS float* tbl = (LAS float*)(lds + NG_TBL);
    LAS float* wsf = (LAS float*)(lds + NG_WSF) + w * 64;
    const int skey = tid >> 3, sch = tid & 7;
    const unsigned kw0 = kv_off(skey, sch, (skey >> 1) & 7), kw1 = kv_off(skey + 64, sch, ((skey + 64) >> 1) & 7);
    const unsigned vw0 = kv_off(skey, sch, ((skey >> 1) & 1) << 2), vw1 = kv_off(skey + 64, sch, (((skey + 64) >> 1) & 1) << 2);
    const int clo_ = clampi(qcol - 8, 0, 48) - kc0 - 4 * hi;
    const int q4 = (lane & 15) >> 2, p4 = lane & 3, blk = (lane >> 4) & 1;
    const unsigned vsw = ((q4 >> 1) & 1) << 2, vx = 2 * blk + (p4 >> 1);
    const unsigned voff0 = (4 * hi + q4) * 128 + ((vx ^ vsw) << 4) + 8 * (p4 & 1), voff1 = (4 * hi + q4) * 128 + (((4 + vx) ^ vsw) << 4) + 8 * (p4 & 1);
    for (int i = tid; i < 640; i += NTHR) tbl[i] = (i >= 64 && i < 64 + 465) ? A.in[17][h * 465 + i - 64] * LOG2E : 0.f;
#pragma unroll
    for (int i = 0; i < 4; ++i) { const int key = skey + 64 * i; const bf16* p_ = KV + ((size_t)M_LAT + b * CTXL + key) * 2048 + h * 64 + sch * 8;
        const v4u kk = *(const GAS v4u*)p_, vv = *(const GAS v4u*)(p_ + 1024);
        *(LAS v4u*)(lds + NG_CK + kv_off(key, sch, (key >> 1) & 7)) = kk; *(LAS v4u*)(lds + NG_CV + kv_off(key, sch, ((key >> 1) & 1) << 2)) = vv; }
    v4u kreg0, kreg1, vreg0, vreg1;
#define NG_RLO(band) clampi(4 * (band) - 4, 0, 56)
#define NG_RHI(band) (clampi(4 * (band) - 1, 0, 56) + 7)
#define NG_LOAD(band, st) do { const int ka_ = NG_RLO(band) + 2 * (st), kb_ = ka_ + 1 > NG_RHI(band) ? NG_RHI(band) : ka_ + 1; \
        const bf16* p0_ = KV + ((size_t)b * SEQ + ka_ * 64 + skey) * 2048 + h * 64 + sch * 8; const bf16* p1_ = KV + ((size_t)b * SEQ + kb_ * 64 + skey) * 2048 + h * 64 + sch * 8; \
        kreg0 = *(const GAS v4u*)p0_; vreg0 = *(const GAS v4u*)(p0_ + 1024); kreg1 = *(const GAS v4u*)p1_; vreg1 = *(const GAS v4u*)(p1_ + 1024); } while (0)
#define NG_STORE(buf) do { lptr kd_ = lds + NG_RK + (buf) * 16384, vd_ = lds + NG_RV + (buf) * 16384; \
        *(LAS v4u*)(kd_ + kw0) = kreg0; *(LAS v4u*)(kd_ + kw1) = kreg1; *(LAS v4u*)(vd_ + vw0) = vreg0; *(LAS v4u*)(vd_ + vw1) = vreg1; } while (0)
#define NG_QLOAD(dst, band) do { const int qrow_ = 4 * (band) + 2 * rp + (r32 >> 4); const bf16* qp_ = ZQ + ((size_t)b * SEQ + qrow_ * 64 + qcol) * 2048 + 1024 + h * 64; \
        _Pragma("unroll") for (int s_ = 0; s_ < 4; ++s_) dst[s_] = *(const bf16x8*)(qp_ + 16 * s_ + 8 * hi); } while (0)
    bf16x8 qf[4], qn[4];
    NG_QLOAD(qf, band0);
    NG_LOAD(band0, 0); NG_STORE(0);
    __syncthreads();
    int cnt = 0;
    for (int ub = 0; ub < 8; ++ub) {
        const int band = band0 + ub;
        const int qr0 = 4 * band + 2 * rp, qrow = qr0 + (r32 >> 4);
        const int rlo = NG_RLO(band), rhi = NG_RHI(band), nrows = rhi - rlo + 1, nsteps = (nrows + 1) >> 1;
        const int rsq = clampi(qrow - 4, 0, 56), rsw0 = clampi(qr0 - 4, 0, 56), rsw1 = clampi(qr0 + 1 - 4, 0, 56) + 7;
        float m_run = 0.f, l_run = 0.f; bool first_tile = true;
        f32x16 o0, o1;
#pragma unroll
        for (int r = 0; r < 16; ++r) { o0[r] = 0.f; o1[r] = 0.f; }
        if (PMODE != 2) {
            lptr kb = lds + NG_CK, vb = lds + NG_CV;
            const bool vA = true, vB = true; const LAS float* tbA = tbl; const LAS float* tbB = tbl; (void)vA; (void)vB; (void)tbA; (void)tbB;
            NA_TILE(0, 32, false); NA_TILE(64, 96, false); NA_TILE(128, 160, false); NA_TILE(192, 224, false);
        }
        for (int st = 0; st < nsteps; ++st) {
            const int buf = cnt & 1;
            if (st + 1 < nsteps) NG_LOAD(band, st + 1);
            else if (ub < 7) { NG_LOAD(band + 1, 0); NG_QLOAD(qn, band + 1); }
            lptr kb = lds + NG_RK + buf * 16384, vb = lds + NG_RV + buf * 16384;
            const int ka = rlo + 2 * st, kbr = ka + 1;
            const bool useA = (ka >= rsw0 && ka <= rsw1), useB = (kbr <= rhi && kbr >= rsw0 && kbr <= rsw1);
            if ((useA || useB) && PMODE != 1) {
                const bool vA = useA && (ka >= rsq && ka < rsq + 8), vB = useB && (kbr >= rsq && kbr < rsq + 8);
                const LAS float* tbA = tbl + 64 + clampi(ka - qrow + 7, 0, 14) * 31 + 15 + kc0 + 4 * hi - qcol;
                const LAS float* tbB = tbl + 64 + clampi(kbr - qrow + 7, 0, 14) * 31 + 15 + kc0 + 4 * hi - qcol;
                NA_TILE(kc0, 64 + kc0, true);
            }
            if (st + 1 < nsteps || ub < 7) NG_STORE(buf ^ 1);
            WG_BAR();
            ++cnt;
        }
        const float lt = l_run + __shfl_xor(l_run, 32);
        if (hi == 0) wsf[r32] = 1.f / lt;
        { const int sb = (cnt & 1) ^ 1;
          LAS unsigned short* stg = (LAS unsigned short*)(lds + (w < 4 ? NG_RK + sb * 16384 + w * 4096 : NG_RV + sb * 16384 + (w - 4) * 4096));
#pragma unroll
          for (int g4 = 0; g4 < 4; ++g4) { const f32x4 iq = *(const LAS f32x4*)(wsf + 8 * g4 + 4 * hi);
#pragma unroll
            for (int e = 0; e < 4; ++e) { const int r = 4 * g4 + e, q = crow(r, hi); const float inv = iq[e];
                stg[q * 64 + r32] = (unsigned short)(cvtpk(o0[r] * inv, 0.f) & 0xffffu);
                stg[q * 64 + 32 + r32] = (unsigned short)(cvtpk(o1[r] * inv, 0.f) & 0xffffu); } }
#pragma unroll
          for (int i = 0; i < 4; ++i) { const int q = i * 8 + (lane >> 3), ch = lane & 7;
            const v4u v = *(const LAS v4u*)(stg + q * 64 + ch * 8);
            const size_t tok = (size_t)b * SEQ + (qr0 + (q >> 4)) * 64 + 16 * jb + (q & 15);
            *(GAS v4u*)(OUT + tok * 2048 + 1024 + h * 64 + ch * 8) = v; } }
        WG_BAR();
#pragma unroll
        for (int s = 0; s < 4; ++s) qf[s] = qn[s];
    }
    __syncthreads();
#undef NG_RLO
#undef NG_RHI
#undef NG_LOAD
#undef NG_STORE
#undef NG_QLOAD
}

constexpr int PREP_WLDS = 16384, PREP_XITEMS = BATCH * NCH * 24, PREP_ITEMS = PREP_XITEMS + BATCH * NCH;
__device__ __forceinline__ unsigned slab_off(unsigned row, unsigned ch) { return row * 128 + ((ch ^ (((row >> 1) & 1) << 2)) << 4); }
__device__ __forceinline__ void prep_item(const Args& A, lptr wl, int item, int lane) {
    if (item < PREP_XITEMS) {
        const int ca = item / 24, cg = item % 24, b = ca / NCH, cid_all = ca % NCH; const bool is_ctx = cid_all < 2;
        if (is_ctx && cg >= 20) return;
        const int cid = is_ctx ? cid_all : cid_all - 2, L = is_ctx ? CTXL : SEQ, t0 = 128 * cid; const size_t rowbase = is_ctx ? (size_t)M_LAT + b * CTXL : (size_t)b * SEQ;
        const bf16* XBC = (const bf16*)(A.ws + WS_XBC);
        const int v = lane & 7, tb = 16 * (lane >> 3), c0 = cg * 64 + v * 8;
        float wgt[3][8], bias[8];
#pragma unroll
        for (int k = 0; k < 3; ++k) { const f32x4 a = *(const f32x4*)(A.in[11] + k * 1536 + c0), c = *(const f32x4*)(A.in[11] + k * 1536 + c0 + 4);
#pragma unroll
            for (int e = 0; e < 4; ++e) { wgt[k][e] = a[e]; wgt[k][4 + e] = c[e]; } }
        { const f32x4 a = *(const f32x4*)(A.in[12] + c0), c = *(const f32x4*)(A.in[12] + c0 + 4);
#pragma unroll
          for (int e = 0; e < 4; ++e) { bias[e] = a[e]; bias[4 + e] = c[e]; } }
        const bf16* src = XBC + (rowbase + t0 + tb) * 1536 + c0;
        const v4u zero4 = {0u, 0u, 0u, 0u};
        v4u up = (t0 + tb - 1 >= 0) ? *(const GAS v4u*)(src - 1536) : zero4, uc = *(const GAS v4u*)src;
        bf16* BC = (bf16*)(A.ws + WS_BC); bf16* CC = (bf16*)(A.ws + WS_CC);
#pragma unroll
        for (int i = 0; i < 16; ++i) {
            const v4u un = (t0 + tb + i + 1 < L) ? *(const GAS v4u*)(src + (size_t)(i + 1) * 1536) : zero4;
            v4u o;
#pragma unroll
            for (int e = 0; e < 4; ++e) {
                const float a0 = bias[2 * e] + wgt[0][2 * e] * bflo(up[e]) + wgt[1][2 * e] * bflo(uc[e]) + wgt[2][2 * e] * bflo(un[e]);
                const float a1 = bias[2 * e + 1] + wgt[0][2 * e + 1] * bfhi(up[e]) + wgt[1][2 * e + 1] * bfhi(uc[e]) + wgt[2][2 * e + 1] * bfhi(un[e]);
                o[e] = cvtpk(silu_f(a0), silu_f(a1)); }
            if (cg < 16) *(LAS v4u*)(wl + slab_off(tb + i, v)) = o;
            else if (cg < 20) *(GAS v4u*)(BC + (rowbase + t0 + tb + i) * 256 + (cg - 16) * 64 + v * 8) = o;
            else *(GAS v4u*)(CC + (rowbase + t0 + tb + i) * 256 + (cg - 20) * 64 + v * 8) = o;
            up = uc; uc = un;
        }
        if (cg < 16) {
            const int r32 = lane & 31, hi = lane >> 5, q4 = (lane & 15) >> 2, p4 = lane & 3, blk = (lane >> 4) & 1;
            bf16* XT = (bf16*)(A.ws + WS_H) + ((size_t)ca * 16 + cg) * 64 * 128;
#pragma unroll
            for (int c = 0; c < 2; ++c)
#pragma unroll
                for (int s = 0; s < 8; ++s) {
                    const unsigned ch = 4 * c + 2 * blk + (p4 >> 1), ra = 16 * s + 4 * hi + q4;
                    const s16x4 lo4 = trd(wl + slab_off(ra, ch) + 8 * (p4 & 1)), hi4 = trd(wl + slab_off(ra + 8, ch) + 8 * (p4 & 1));
                    *(GAS bf16x8*)(XT + (size_t)((c * 8 + s) * 64 + lane) * 8) = cat8(lo4, hi4);
                }
        }
        return;
    }
    {
        const int ca = item - PREP_XITEMS, b = ca / NCH, cid_all = ca % NCH; const bool is_ctx = cid_all < 2;
        const int cid = is_ctx ? cid_all : cid_all - 2, t0 = 128 * cid; const size_t rowbase = is_ctx ? (size_t)M_LAT + b * CTXL : (size_t)b * SEQ;
        const float* DTRAW = (const float*)(A.ws + WS_DTRAW) + (rowbase + t0) * 32;
        LAS float* las = (LAS float*)wl;
        float* LA = (float*)(A.ws + WS_LA); float* LD = (float*)(A.ws + WS_LD);
        const size_t obase = (size_t)(b * 2) * 16 * (NCH * 128) + cid_all * 128;
        const int jq = lane & 7;
        const f32x4 bj4 = *(const f32x4*)(A.in[13] + 4 * jq);
        f32x4 dtv[16];
#pragma unroll
        for (int i2 = 0; i2 < 16; ++i2) { const int t = (lane >> 3) + 8 * i2; const f32x4 raw = *(const GAS f32x4*)(DTRAW + t * 32 + 4 * jq);
#pragma unroll
            for (int e = 0; e < 4; ++e) dtv[i2][e] = softplus_f(raw[e] + bj4[e]); }
#pragma unroll
        for (int i2 = 0; i2 < 16; ++i2) { const int t = (lane >> 3) + 8 * i2;
#pragma unroll
            for (int e = 0; e < 4; ++e) { const int jj = 4 * jq + e; las[jj * 128 + ((t + jj) & 127)] = dtv[i2][e]; } }
        if (lane < 32) { const int jl = lane; const float Aj = -__expf(A.in[14][jl]) * LOG2E; float acc = 0.f;
            if (jl < 16) { for (int t = 0; t < 128; ++t) { const int o = jl * 128 + ((t + jl) & 127); acc += las[o] * Aj; las[o] = acc; } }
            else { for (int t = 127; t >= 0; --t) { const int o = jl * 128 + ((t + jl) & 127); acc += las[o] * Aj; las[o] = acc; } }
            ((float*)(A.ws + WS_ATOT))[((size_t)(b * 2) * 16 + jl) * NCH + cid_all] = acc; }
        for (int i = lane; i < 4096; i += 64) { const int jj = i >> 7, t = i & 127; LA[obase + (size_t)jj * (NCH * 128) + t] = las[jj * 128 + ((t + jj) & 127)]; }
#pragma unroll
        for (int i2 = 0; i2 < 16; ++i2) { const int t = (lane >> 3) + 8 * i2;
#pragma unroll
            for (int e = 0; e < 4; ++e) { const int jj = 4 * jq + e; las[jj * 128 + ((t + jj) & 127)] = __log2f(dtv[i2][e]); } }
        for (int i = lane; i < 4096; i += 64) { const int jj = i >> 7, t = i & 127; LD[obase + (size_t)jj * (NCH * 128) + t] = las[jj * 128 + ((t + jj) & 127)]; }
    }
}
constexpr int SD_BS = 0, SD_HS = 32768, SD_W = 49152;
constexpr size_t WS_HST = WS_KV;
template <int PMODE>
__device__ __forceinline__ void ssd_state_unit(const Args& A, lptr lds, int b, int h, int dir, int tid) {
    const int lane = tid & 63, w = __builtin_amdgcn_readfirstlane(tid >> 6), r32 = lane & 31, hi = lane >> 5, it = w >> 1, pt = w & 1, g = h >> 3;
    const bf16* BC = (const bf16*)(A.ws + WS_BC); const bf16* XT = (const bf16*)(A.ws + WS_H);
    const float* LA = (const float*)(A.ws + WS_LA) + ((size_t)(b * 2 + dir) * 16 + h) * (NCH * 128);
    const float* LD = (const float*)(A.ws + WS_LD) + ((size_t)(b * 2 + dir) * 16 + h) * (NCH * 128);
    const float* ATOT = (const float*)(A.ws + WS_ATOT) + ((size_t)(b * 2 + dir) * 16 + h) * NCH;
    bf16* HST = (bf16*)(A.ws + WS_HST);
    f32x16 st;
#pragma unroll
    for (int r = 0; r < 16; ++r) st[r] = 0.f;
    bf16x8 xnA[8], xnB[8]; v4u pbA[4], pbB[4]; float laA[4], ldA[4], laB[4], ldB[4], atA = 0.f, atB = 0.f;
    const int q4 = (lane & 15) >> 2, p4 = lane & 3, blk = (lane >> 4) & 1;
#define SD_CID(k) (dir == 0 ? (k) : ((k) < 2 ? 1 - (k) : 35 - (k)))
#define SD_PREFETCH_B(k, PB, LAN, LDN, ATN) do { const int ca_ = SD_CID(k); const bool cx_ = ca_ < 2; \
        const size_t rb_ = cx_ ? (size_t)M_LAT + b * CTXL + 128 * ca_ : (size_t)b * SEQ + 128 * (ca_ - 2); \
        _Pragma("unroll") for (int i_ = 0; i_ < 4; ++i_) { const int idx_ = tid + NTHR * i_, row_ = idx_ >> 4, ch_ = idx_ & 15; \
            PB[i_] = *(const GAS v4u*)(BC + (rb_ + row_) * 256 + g * 128 + ch_ * 8); } \
        _Pragma("unroll") for (int i_ = 0; i_ < 4; ++i_) { const int row_ = (tid >> 4) + 32 * i_; LAN[i_] = LA[ca_ * 128 + row_]; LDN[i_] = LD[ca_ * 128 + row_]; } ATN = ATOT[ca_]; } while (0)
#define SD_PREFETCH_X(k, XN) do { const int ca_ = SD_CID(k); \
        const bf16* xp_ = XT + (((size_t)b * NCH + ca_) * 16 + h) * (64 * 128) + (size_t)(pt * 8 * 64 + lane) * 8; \
        _Pragma("unroll") for (int s_ = 0; s_ < 8; ++s_) XN[s_] = *(const GAS bf16x8*)(xp_ + s_ * 512); } while (0)
#define SD_STEP(k, PB, XN, LAN, LDN, ATN) do { \
        const int ca = SD_CID(k); const bool is_ctx = ca < 2; lptr ldb = lds + ((k) & 1) * 49152; \
        const float atot = ATN; \
        _Pragma("unroll") for (int i = 0; i < 4; ++i) { const int idx = tid + NTHR * i, row = idx >> 4, ch = idx & 15; \
            const float wv_ = __builtin_amdgcn_exp2f(atot - LAN[i] + LDN[i]);        \
            v4u q_ = PB[i]; q_.x = cvtpk(bflo(q_.x) * wv_, bfhi(q_.x) * wv_); q_.y = cvtpk(bflo(q_.y) * wv_, bfhi(q_.y) * wv_); q_.z = cvtpk(bflo(q_.z) * wv_, bfhi(q_.z) * wv_); q_.w = cvtpk(bflo(q_.w) * wv_, bfhi(q_.w) * wv_); \
            *(LAS v4u*)(ldb + SD_BS + off_b(row, ch)) = q_; } \
        if (!is_ctx) { \
            _Pragma("unroll") for (int g4 = 0; g4 < 4; ++g4) { const unsigned lo = cvtpk(st[4 * g4], st[4 * g4 + 1]), hi2 = cvtpk(st[4 * g4 + 2], st[4 * g4 + 3]); \
                const unsigned long long v = (unsigned long long)lo | ((unsigned long long)hi2 << 32); \
                *(LAS unsigned long long*)(ldb + SD_HS + off_b(32 * pt + r32, 4 * it + g4) + 8 * hi) = v; } \
        } \
        WG_BAR(); \
        if ((k) + 2 < NCH) SD_PREFETCH_B((k) + 2, PB, LAN, LDN, ATN); \
        if (!is_ctx && PMODE != 2) { \
            bf16* dst = HST + ((((size_t)b * 32 + (ca - 2)) * 16 + h) * 2 + dir) * (64 * 128); \
            _Pragma("unroll") for (int i = 0; i < 2; ++i) { const int idx = tid + NTHR * i, f_ = idx >> 6, ln_ = idx & 63, row = 32 * (f_ >> 3) + (ln_ & 31), ch = 2 * (f_ & 7) + (ln_ >> 5);     \
                *(GAS v4u*)(dst + (size_t)idx * 8) = *(const LAS v4u*)(ldb + SD_HS + off_b(row, ch)); } \
        } \
        { int hiv = hi, q4v = q4, p4v = p4; asm volatile("" : "+v"(hiv), "+v"(q4v), "+v"(p4v)); \
          const float dec = __builtin_amdgcn_exp2f(atot); \
          _Pragma("unroll") for (int r = 0; r < 16; ++r) st[r] *= dec; \
          if (PMODE != 1) _Pragma("unroll") for (int s = 0; s < 8; ++s) { \
              const unsigned ch = 4 * it + 2 * blk + (p4v >> 1); \
              const s16x4 lo4 = trd(ldb + SD_BS + off_b(16 * s + 4 * hiv + q4v, ch) + 8 * (p4v & 1)); \
              const s16x4 hi4 = trd(ldb + SD_BS + off_b(16 * s + 8 + 4 * hiv + q4v, ch) + 8 * (p4v & 1)); \
              st = MFMA32(cat8(lo4, hi4), XN[s], st); \
          } } \
        if ((k) + 2 < NCH) SD_PREFETCH_X((k) + 2, XN); } while (0)
    SD_PREFETCH_B(0, pbA, laA, ldA, atA); SD_PREFETCH_X(0, xnA); SD_PREFETCH_B(1, pbB, laB, ldB, atB); SD_PREFETCH_X(1, xnB);
    SD_STEP(0, pbA, xnA, laA, ldA, atA);
    SD_STEP(1, pbB, xnB, laB, ldB, atB);
#pragma unroll 1
    for (int k = 2; k < NCH; k += 8) {
        SD_STEP(k, pbA, xnA, laA, ldA, atA); SD_STEP(k + 1, pbB, xnB, laB, ldB, atB);
        SD_STEP(k + 2, pbA, xnA, laA, ldA, atA); SD_STEP(k + 3, pbB, xnB, laB, ldB, atB);
        SD_STEP(k + 4, pbA, xnA, laA, ldA, atA); SD_STEP(k + 5, pbB, xnB, laB, ldB, atB);
        SD_STEP(k + 6, pbA, xnA, laA, ldA, atA); SD_STEP(k + 7, pbB, xnB, laB, ldB, atB);
    }
    __syncthreads();
#undef SD_STEP
#undef SD_CID
#undef SD_PREFETCH_B
#undef SD_PREFETCH_X
}
constexpr int SY_BS = 0, SY_CS = 32768, SY_LA = 65536, SY_BJ = SY_LA + 8192, SY_GX = SY_BJ + 8192;
template <int PMODE>
__device__ __forceinline__ void ssd_y_unit(const Args& A, lptr lds, int b, int c, int tid) {
    const int lane = tid & 63, w = __builtin_amdgcn_readfirstlane(tid >> 6), r32 = lane & 31, hi = lane >> 5, it = w >> 1, pt = w & 1;
    const bf16* BC = (const bf16*)(A.ws + WS_BC); const bf16* CC = (const bf16*)(A.ws + WS_CC); const bf16* XT = (const bf16*)(A.ws + WS_H);
    const bf16* HST = (const bf16*)(A.ws + WS_HST); bf16* ZQ = (bf16*)(A.ws + WS_ZQ); bf16* YT = (bf16*)(A.ws + WS_YTMP);
    const float* LA = (const float*)(A.ws + WS_LA); const float* LD = (const float*)(A.ws + WS_LD);
    const size_t tok0 = (size_t)b * SEQ + 128 * c;
    for (int g = 0; g < 2; ++g) {
#pragma unroll
        for (int i = 0; i < 4; ++i) { const int idx = tid + NTHR * i, row = idx >> 4, ch = idx & 15;
            const v4u vb_ = *(const GAS v4u*)(BC + (tok0 + row) * 256 + g * 128 + ch * 8);
            *(LAS v4u*)(lds + SY_BS + off_b(row, ch)) = vb_; }
        asm volatile("" ::: "memory");
#pragma unroll
        for (int i = 0; i < 4; ++i) { const int idx = tid + NTHR * i, row = idx >> 4, ch = idx & 15;
            const v4u vc_ = *(const GAS v4u*)(CC + (tok0 + row) * 256 + g * 128 + ch * 8);
            *(LAS v4u*)(lds + SY_CS + off_b(row, ch)) = vc_; }
        asm volatile("" ::: "memory");
#pragma unroll
        for (int i = 0; i < 4; ++i) { const int idx = tid + NTHR * i, combo = idx >> 7, t = idx & 127, dir = combo >> 3, hl = combo & 7;
            const size_t o = ((size_t)(b * 2 + dir) * 16 + g * 8 + hl) * (NCH * 128) + (2 + c) * 128 + t;
            const float la = LA[o], ld = LD[o];
            ((LAS float*)(lds + SY_LA))[combo * 128 + t] = la; ((LAS float*)(lds + SY_BJ))[combo * 128 + t] = la - ld; }
        WG_BAR();
        int r32v = r32, hiv = hi; asm volatile("" : "+v"(r32v), "+v"(hiv));
        lptr gpl = lds + (w < 4 ? SY_BS + w * 8192 : SY_GX + (w - 4) * 8192) + lane * 16;
        {
        v4u Gp[4][2];
        bf16x8 cf[8];
#pragma unroll
        for (int s = 0; s < 8; ++s) cf[s] = *(const LAS bf16x8*)(lds + SY_CS + off_b(32 * it + r32v, 2 * s + hiv));
#pragma unroll
        for (int jt = 0; jt < 4; ++jt) {
            f32x16 gt;
#pragma unroll
            for (int r = 0; r < 16; ++r) gt[r] = 0.f;
#pragma unroll
            for (int s = 0; s < 8; ++s) { const bf16x8 a = *(const LAS bf16x8*)(lds + SY_BS + off_b(32 * jt + r32v, 2 * s + hiv)); gt = MFMA32(a, cf[s], gt); }
#pragma unroll
            for (int j = 0; j < 4; ++j) { Gp[jt][0][j] = cvtpk(gt[2 * j], gt[2 * j + 1]); Gp[jt][1][j] = cvtpk(gt[8 + 2 * j], gt[8 + 2 * j + 1]); }
        }
        WG_BAR();
#pragma unroll
        for (int jt = 0; jt < 4; ++jt) { *(LAS v4u*)(gpl + (jt * 2) * 1024) = Gp[jt][0]; *(LAS v4u*)(gpl + (jt * 2 + 1) * 1024) = Gp[jt][1]; }
        }
        bf16x8 hs[8];
#define SY_HS_LOAD(dst, head_, dir_, pt_) do { const bf16* hp_ = HST + ((((size_t)b * 32 + c) * 16 + (head_)) * 2 + (dir_)) * (64 * 128) + (size_t)((pt_) * 8 * 64 + lane) * 8; \
            _Pragma("unroll") for (int s_ = 0; s_ < 8; ++s_) dst[s_] = (PMODE == 3) ? (bf16x8){1, 2, 3, 4, 5, 6, 7, (short)r32} : *(const GAS bf16x8*)(hp_ + s_ * 512); } while (0)
#define SY_YOFF(hs_, dir_, pt_) do { const LAS float* la_ = (const LAS float*)(lds + SY_LA) + ((dir_) * 8 + hl) * 128; f32x16 t_; \
            _Pragma("unroll") for (int r = 0; r < 16; ++r) t_[r] = 0.f; \
            _Pragma("unroll") for (int s = 0; s < 8; ++s) { const bf16x8 cfs = *(const LAS bf16x8*)(lds + SY_CS + off_b(32 * it + r32v, 2 * s + hiv)); t_ = MFMA32(cfs, hs_[s], t_); } \
            _Pragma("unroll") for (int g4 = 0; g4 < 4; ++g4) { const f32x4 a_ = *(const LAS f32x4*)(la_ + 32 * it + 8 * g4 + 4 * hiv); \
                _Pragma("unroll") for (int e = 0; e < 4; ++e) acc[pt_][4 * g4 + e] += t_[4 * g4 + e] * __builtin_amdgcn_exp2f(a_[e]); } } while (0)
#define SY_DIAG(dir) do { \
                const LAS float* la_s = (const LAS float*)(lds + SY_LA) + ((dir) * 8 + hl) * 128; const LAS float* bj_s = (const LAS float*)(lds + SY_BJ) + ((dir) * 8 + hl) * 128; \
                const float ai = la_s[32 * it + r32]; \
                _Pragma("unroll") for (int jt = 0; jt < 4; ++jt) { \
                    if ((dir) == 0 ? (jt <= it) : (jt >= it)) { \
                        float gv[16]; \
                        { const v4u g0 = *(const LAS v4u*)(gpl + (jt * 2) * 1024), g1 = *(const LAS v4u*)(gpl + (jt * 2 + 1) * 1024); \
                          _Pragma("unroll") for (int j = 0; j < 4; ++j) { gv[2 * j] = bflo(g0[j]); gv[2 * j + 1] = bfhi(g0[j]); gv[8 + 2 * j] = bflo(g1[j]); gv[8 + 2 * j + 1] = bfhi(g1[j]); } } \
                        { int dd = (jt == it) ? (r32v - 4 * hiv) : ((dir) == 0 ? 1000 : -1000); asm volatile("" : "+v"(dd));     \
                          _Pragma("unroll") for (int g4 = 0; g4 < 4; ++g4) { const f32x4 bq = *(const LAS f32x4*)(bj_s + 32 * jt + 8 * g4 + 4 * hiv); \
                            _Pragma("unroll") for (int e = 0; e < 4; ++e) { const int r = 4 * g4 + e, cr = e + 8 * g4; \
                                const bool valid = ((dir) == 0) ? (cr <= dd) : (cr >= dd); \
                                gv[r] *= __builtin_amdgcn_exp2f(valid ? (ai - bq[e]) : -10000.f); \
                                if ((dir) == 0) gv[r] += (cr == dd) ? dskip : 0.f; } } } \
                        v4u u0, u1; \
                        _Pragma("unroll") for (int j = 0; j < 4; ++j) { u0[j] = cvtpk(gv[2 * j], gv[2 * j + 1]); u1[j] = cvtpk(gv[8 + 2 * j], gv[8 + 2 * j + 1]); } \
                        _Pragma("unroll") for (int p2 = 0; p2 < 2; ++p2) { \
                            acc[p2] = MFMA32(__builtin_bit_cast(bf16x8, u0), xf[p2][2 * jt], acc[p2]); \
                            acc[p2] = MFMA32(__builtin_bit_cast(bf16x8, u1), xf[p2][2 * jt + 1], acc[p2]); } \
                    } } } while (0)
        const int hp = w & 1;
        SY_HS_LOAD(hs, 8 * g + hp, 0, 0);
        for (int hq = 0; hq < 4; ++hq) {
            const int hl = 2 * hq + hp, head = 8 * g + hl;
            asm volatile("" : "+v"(r32v), "+v"(hiv));
            bf16x8 xf[2][8];
#pragma unroll
            for (int p2 = 0; p2 < 2; ++p2) { const bf16* xp = XT + (((size_t)b * NCH + 2 + c) * 16 + head) * (64 * 128) + (size_t)(p2 * 8 * 64 + lane) * 8;
#pragma unroll
              for (int s = 0; s < 8; ++s) xf[p2][s] = (PMODE == 3) ? (bf16x8){1, 2, 3, 4, 5, 6, 7, (short)hi} : *(const GAS bf16x8*)(xp + s * 512); }
            const float dskip = A.in[15][head];
            f32x16 acc[2];
#pragma unroll
            for (int r = 0; r < 16; ++r) { acc[0][r] = 0.f; acc[1][r] = 0.f; }
            SY_YOFF(hs, 0, 0); __builtin_amdgcn_sched_barrier(0);
            SY_HS_LOAD(hs, head, 0, 1); __builtin_amdgcn_sched_barrier(0);
            if (PMODE != 2) SY_DIAG(0);
            __builtin_amdgcn_sched_barrier(0);
            SY_YOFF(hs, 0, 1); __builtin_amdgcn_sched_barrier(0);
            SY_HS_LOAD(hs, head, 1, 0); __builtin_amdgcn_sched_barrier(0);
            if (PMODE != 2) SY_DIAG(1);
            __builtin_amdgcn_sched_barrier(0);
            SY_YOFF(hs, 1, 0); __builtin_amdgcn_sched_barrier(0);
            SY_HS_LOAD(hs, head, 1, 1); __builtin_amdgcn_sched_barrier(0);
            SY_YOFF(hs, 1, 1); __builtin_amdgcn_sched_barrier(0);
            if (hq < 3) SY_HS_LOAD(hs, head + 2, 0, 0);
            __builtin_amdgcn_sched_barrier(0);
#pragma unroll
            for (int p2 = 0; p2 < 2; ++p2) { bf16* yp = YT + (tok0 + 32 * it) * 1024 + head * 64 + 32 * p2 + r32;
#pragma unroll
                for (int r = 0; r < 16; ++r) yp[(size_t)crow(r, hi) * 1024] = (bf16)(cvtpk(acc[p2][r], 0.f) & 0xffffu); }
        }
#undef SY_YOFF
#undef SY_DIAG
#undef SY_HS_LOAD
        WG_BAR();
    }
    __syncthreads();
    if (PMODE != 0) return;
    { const float* nw = A.in[16];
      f32x4 nwv[4];
#pragma unroll
      for (int j = 0; j < 2; ++j) { nwv[2 * j] = *(const f32x4*)(nw + 8 * lane + 512 * j); nwv[2 * j + 1] = *(const f32x4*)(nw + 8 * lane + 512 * j + 4); }
      for (int rq = 0; rq < 4; ++rq) {
        v4u yv[4][2], zv[4][2];
#pragma unroll
        for (int u = 0; u < 4; ++u) { const size_t row = tok0 + w * 16 + rq * 4 + u;
#pragma unroll
            for (int j = 0; j < 2; ++j) { const int cc = 8 * lane + 512 * j; yv[u][j] = *(const GAS v4u*)(YT + row * 1024 + cc); zv[u][j] = *(const GAS v4u*)(ZQ + row * 2048 + cc); } }
#pragma unroll
        for (int u = 0; u < 4; ++u) { const size_t row = tok0 + w * 16 + rq * 4 + u;
            float gv[16]; float s = 0.f;
#pragma unroll
            for (int j = 0; j < 2; ++j)
#pragma unroll
                for (int e = 0; e < 4; ++e) { const float g0 = bflo(yv[u][j][e]) * silu_f(bflo(zv[u][j][e])), g1 = bfhi(yv[u][j][e]) * silu_f(bfhi(zv[u][j][e])); gv[8 * j + 2 * e] = g0; gv[8 * j + 2 * e + 1] = g1; s += g0 * g0 + g1 * g1; }
            const float rstd = rsqrtf(wave_sum(s) * (1.f / 1024.f) + RMS_EPS);
#pragma unroll
            for (int j = 0; j < 2; ++j) { const int cc = 8 * lane + 512 * j; v4u o;
#pragma unroll
                for (int e = 0; e < 4; ++e) { const f32x4 wq = nwv[2 * j + (e >> 1)]; o[e] = cvtpk(gv[8 * j + 2 * e] * rstd * wq[(2 * e) & 3], gv[8 * j + 2 * e + 1] * rstd * wq[(2 * e + 1) & 3]); }
                *(GAS v4u*)(ZQ + row * 2048 + cc) = o; } } } }
    __syncthreads();
}
__device__ __forceinline__ void conv1_phase(const Args& A, int tid, int vcu, int G) {
    const bf16* P1 = (const bf16*)(A.ws + WS_P1); bf16* G1 = (bf16*)(A.ws + WS_G1); const float* cw = A.in[20];
    const int gt = vcu * NTHR + tid, NGT = G * NTHR;
    for (int item = gt; item < (M_LAT / 16) * 128; item += NGT) {
        const int rb = item >> 7, c0 = (item & 127) * 8, r0 = rb * 16, t0 = r0 & (SEQ - 1);
        float w[3][8];
#pragma unroll
        for (int k = 0; k < 3; ++k) { const f32x4 a = *(const f32x4*)(cw + k * 1024 + c0), b2 = *(const f32x4*)(cw + k * 1024 + c0 + 4);
#pragma unroll
            for (int e = 0; e < 4; ++e) { w[k][e] = a[e]; w[k][4 + e] = b2[e]; } }
        const bf16* src = P1 + (size_t)r0 * 2048 + c0;
        const v4u zero4 = {0u, 0u, 0u, 0u};
        v4u up = (t0 > 0) ? *(const GAS v4u*)(src - 2048 + 1024) : zero4, uc = *(const GAS v4u*)(src + 1024);
#pragma unroll
        for (int i = 0; i < 16; ++i) {
            const v4u un = (t0 + i + 1 < SEQ) ? *(const GAS v4u*)(src + (size_t)(i + 1) * 2048 + 1024) : zero4;
            const v4u gb = *(const GAS v4u*)(src + (size_t)i * 2048); v4u o;
#pragma unroll
            for (int e = 0; e < 4; ++e) { const float a0 = w[0][2 * e] * bflo(up[e]) + w[1][2 * e] * bflo(uc[e]) + w[2][2 * e] * bflo(un[e]);
                const float a1 = w[0][2 * e + 1] * bfhi(up[e]) + w[1][2 * e + 1] * bfhi(uc[e]) + w[2][2 * e + 1] * bfhi(un[e]);
                o[e] = cvtpk(bflo(gb[e]) * a0, bfhi(gb[e]) * a1); }
            *(GAS v4u*)(G1 + (size_t)(r0 + i) * 1024 + c0) = o;
            up = uc; uc = un;
        }
    }
}
#define MK_MODE 2
#define PROBE_DUP 0
#define STAGGER_US 0
constexpr int N_PHASES = 18;
__global__ void __launch_bounds__(NTHR, 2) mk_fwd(Args args) {
    extern __shared__ __attribute__((aligned(16))) unsigned char lds_raw[];
    lptr lds = (lptr)lds_raw;
    const int tid = threadIdx.x, G = gridDim.x;
    const int bx = blockIdx.x, vcu = (G % 8 == 0) ? (bx % 8) * (G / 8) + bx / 8 : bx;
    unsigned char* ws = args.ws;
    const int lo = args.ph_lo, hi = args.ph_hi;
    for (int u = tid; u < (LDS_BYTES - LDSCTL_OFF) / 4; u += NTHR) ((LAS unsigned*)(lds + LDSCTL_OFF))[u] = 0u;
    __syncthreads();
    XcdBarrier bar; bar.bar = (unsigned*)(ws + WS_CTL); bar.x = 0; bar.st = nullptr;
    if (hi - lo > 1 && !args.use_cg) bar = xcd_barrier_post((unsigned*)(ws + WS_CTL), (volatile LAS unsigned*)(lds + MISC_OFF) + 8);
#ifndef PROBE_DUP
#define PROBE_DUP 0
#endif
#ifndef MLPUP_SP2
#define MLPUP_SP2 true
#endif
#ifndef RES_ALIGN
#define RES_ALIGN true
#endif
#ifndef STAGGER_US
#define STAGGER_US 0
#endif
#ifndef PH_MASK
#define PH_MASK 0x3ffff
#endif
#define IN(k) (((PH_MASK >> (k)) & 1) && lo <= (k) && (k) < hi)
#define SEAM(k) do { if (IN(k) && IN((k) + 1)) { if (args.use_cg) { cg::this_grid().sync(); } else { xcd_barrier(bar); if (PROBE_DUP & 262144) xcd_barrier(bar); } } } while (0)
#define STAGGER(us) do { if ((us) > 0 && (vcu & 1)) { const unsigned long long t0_ = __builtin_amdgcn_s_memrealtime(); while (__builtin_amdgcn_s_memrealtime() - t0_ < (unsigned long long)(us) * 100ull) __builtin_amdgcn_s_sleep(16); } } while (0)
    bf16* XB = (bf16*)(ws + WS_XB);
    const float* MOD = (const float*)(ws + WS_MOD); const float* WSV = (const float*)(ws + WS_WSV); float* SSQ = (float*)(ws + WS_SSQ); const float* BIASB = (const float*)(ws + WS_BIASB);
    bf16* H = (bf16*)(ws + WS_H);

    if (IN(0)) { p0_prologue(args, lds, tid, vcu, G); } SEAM(0);
    if (IN(1)) { early_weights(args, lds, tid, vcu, G); norm_phase(args, args.in[0], args.in[6], 0, 0, true, tid, vcu, G); } SEAM(1);
    if (IN(2)) {
        pg8::Gemm g{H, (const bf16*)(ws + WS_WIN), M_ALL, NIN0, D}; pg8::InProjOrder S{G, bx};
        pg8::EpiInProj E{(bf16*)(ws + WS_XBC), (bf16*)(ws + WS_ZQ), (bf16*)(ws + WS_KV), (float*)(ws + WS_DTRAW)};
        for (int rep = 0; rep < ((PROBE_DUP & 256) ? 2 : 1); ++rep)
        pg8::gemm_phase<pg8::EpiInProj, pg8::InProjOrder, true, true>(lds, g, S, E);
    } SEAM(2);
    if (IN(3)) {
        if (bx == G - 1) wsv_phase(args, tid);
        if (PROBE_DUP & 1) for (int u = vcu; u < 256; u += G) na_group<0>(args, lds, u >> 5, (u >> 1) & 15, (u & 1) * 8, tid, (bf16*)args.out);
        if (PROBE_DUP & 8192) for (int u = vcu; u < 256; u += G) na_group<3>(args, lds, u >> 5, (u >> 1) & 15, (u & 1) * 8, tid, (bf16*)args.out);
        if (PROBE_DUP & 16384) for (int u = vcu; u < 256; u += G) na_group<4>(args, lds, u >> 5, (u >> 1) & 15, (u & 1) * 8, tid, (bf16*)args.out);
        if (PROBE_DUP & 524288) for (int u = vcu; u < 256; u += G) na_group<5>(args, lds, u >> 5, (u >> 1) & 15, (u & 1) * 8, tid, (bf16*)args.out);
        for (int u = vcu; u < 256; u += G) na_group<0>(args, lds, u >> 5, (u >> 1) & 15, (u & 1) * 8, tid, (bf16*)(ws + WS_ZQ));
        { const int wave = __builtin_amdgcn_readfirstlane(tid >> 6), lane = tid & 63, pq = bx & 7;
          unsigned* tk = (unsigned*)(ws + WS_TICKET) + 64 * pq;
          unsigned tv = 0u; if (lane == 0) tv = __hip_atomic_fetch_add(tk, 1u, __ATOMIC_RELAXED, __HIP_MEMORY_SCOPE_AGENT);
#define PREP_POS(t_) ((int)(((t_) >> 3) * 64u + 8u * (unsigned)pq + ((t_) & 7u)))
          int pos = PREP_POS(__builtin_amdgcn_readfirstlane(tv));
          while (pos < PREP_ITEMS) {
              unsigned tn = 0u; if (lane == 0) tn = __hip_atomic_fetch_add(tk, 1u, __ATOMIC_RELAXED, __HIP_MEMORY_SCOPE_AGENT);
              prep_item(args, lds + wave * PREP_WLDS, pos < BATCH * NCH ? PREP_XITEMS + pos : pos - BATCH * NCH, lane);
              pos = PREP_POS(__builtin_amdgcn_readfirstlane(tn));
          } }
#undef PREP_POS
    } SEAM(3);
    if (IN(4)) {
        if (PROBE_DUP & 4) for (int u = bx; u < 256; u += G) { const int b = u & 7, j = u >> 3; ssd_state_unit<0>(args, lds, b, j & 15, j >> 4, tid); }
        if (PROBE_DUP & 32768) for (int u = bx; u < 256; u += G) { const int b = u & 7, j = u >> 3; ssd_state_unit<1>(args, lds, b, j & 15, j >> 4, tid); }
        if (PROBE_DUP & 65536) for (int u = bx; u < 256; u += G) { const int b = u & 7, j = u >> 3; ssd_state_unit<2>(args, lds, b, j & 15, j >> 4, tid); }
        for (int u = bx; u < 256; u += G) { const int b = u & 7, j = u >> 3; ssd_state_unit<0>(args, lds, b, j & 15, j >> 4, tid); }
    } SEAM(4);
    if (IN(5)) {
        if (PROBE_DUP & 1024) for (int u = bx; u < 256; u += G) { const int b = u & 7, cch = u >> 3; ssd_y_unit<1>(args, lds, b, cch, tid); }
        if (PROBE_DUP & 2048) for (int u = bx; u < 256; u += G) { const int b = u & 7, cch = u >> 3; ssd_y_unit<2>(args, lds, b, cch, tid); }
        if (PROBE_DUP & 4096) for (int u = bx; u < 256; u += G) { const int b = u & 7, cch = u >> 3; ssd_y_unit<3>(args, lds, b, cch, tid); }
        for (int u = bx; u < 256; u += G) { const int b = u & 7, cch = u >> 3; ssd_y_unit<0>(args, lds, b, cch, tid); }
        __syncthreads(); late_weights(args, lds, tid, vcu, G);
    } SEAM(5);
    if (IN(6)) {
        pg8::Gemm g{(const bf16*)(ws + WS_ZQ), (const bf16*)(ws + WS_WOUT), M_LAT, D, 2 * D}; pg8::StaticOrder S; S.init(M_LAT, D, G, bx);
        pg8::EpiResid<true, true> E{args.in[0], XB, MOD + 2 * D, 6 * D, H, WSV, SSQ};
        pg8::gemm_phase<pg8::EpiResid<true, true>, pg8::StaticOrder, RES_ALIGN, true>(lds, g, S, E);
    } SEAM(6);
    if (IN(8)) {
        pg8::Gemm g{H, (const bf16*)(ws + WS_W1T0), M_LAT, DFF, D}; pg8::StaticOrder S; S.init(M_LAT, DFF, G, bx);
        pg8::EpiBf16Act<1, true> E{(bf16*)(ws + WS_HID), DFF, SSQ, BIASB, 4096};
        if (PROBE_DUP & 32) pg8::gemm_phase<pg8::EpiBf16Act<1, true>, pg8::StaticOrder, true, MLPUP_SP2>(lds, g, S, E);
        if (PROBE_DUP & 512) { pg8::EpiProbeAct<0> EP{(bf16*)(ws + WS_HID), DFF, SSQ, BIASB, 4096}; pg8::gemm_phase<pg8::EpiProbeAct<0>, pg8::StaticOrder, true, true>(lds, g, S, EP); }
        if (PROBE_DUP & 131072) { pg8::EpiProbeAct<1> EP{(bf16*)(ws + WS_DTRAW), DFF, SSQ, BIASB, 4096}; pg8::gemm_phase<pg8::EpiProbeAct<1>, pg8::StaticOrder, true, true>(lds, g, S, EP); }
        pg8::gemm_phase<pg8::EpiBf16Act<1, true>, pg8::StaticOrder, true, MLPUP_SP2>(lds, g, S, E);
    } SEAM(8);
    if (IN(9)) {
        pg8::Gemm g{(const bf16*)(ws + WS_HID), (const bf16*)(ws + WS_W2T0), M_LAT, D, DFF}; pg8::StaticOrder S; S.init(M_LAT, D, G, bx);
        pg8::EpiResid<true, false> E{XB, XB, MOD + 5 * D, 6 * D, H, WSV + 8 * 1024, SSQ + M_LAT};
        pg8::gemm_phase<pg8::EpiResid<true, false>, pg8::StaticOrder, RES_ALIGN, true>(lds, g, S, E);
    } SEAM(9);
    if (IN(11)) {
        pg8::Gemm g{H, (const bf16*)(ws + WS_SCIN), M_LAT, 3 * D, D}; pg8::StaticOrder S; S.init(M_LAT, 3 * D, G, bx);
        pg8::EpiScIn E{(bf16*)(ws + WS_P1), SSQ + M_LAT, BIASB + 8 * 4096, 4096};
        pg8::gemm_phase<pg8::EpiScIn, pg8::StaticOrder, true, true>(lds, g, S, E);
    } SEAM(11);
    if (IN(12)) { for (int rep = 0; rep < ((PROBE_DUP & 128) ? 2 : 1); ++rep) conv1_phase(args, tid, vcu, G); } SEAM(12);
    if (IN(13)) {
        pg8::Gemm g{(const bf16*)(ws + WS_G1), (const bf16*)(ws + WS_SCOUT), M_LAT, D, D}; pg8::StaticOrder S; S.init(M_LAT, D, G, bx);
        pg8::EpiResid<true, false> E{XB, XB, MOD + (size_t)8 * 6 * D + 2 * D, 6 * D, H, WSV + 16 * 1024, SSQ + 2 * M_LAT};
        pg8::gemm_phase<pg8::EpiResid<true, false>, pg8::StaticOrder, RES_ALIGN, true>(lds, g, S, E);
    } SEAM(13);
    if (IN(15)) {
        pg8::Gemm g{H, (const bf16*)(ws + WS_W1T1), M_LAT, DFF, D}; pg8::StaticOrder S; S.init(M_LAT, DFF, G, bx);
        pg8::EpiBf16Act<1, true> E{(bf16*)(ws + WS_HID), DFF, SSQ + 2 * M_LAT, BIASB + 2 * 8 * 4096, 4096};
        pg8::gemm_phase<pg8::EpiBf16Act<1, true>, pg8::StaticOrder, true, MLPUP_SP2>(lds, g, S, E);
    } SEAM(15);
    if (IN(16)) {
        pg8::Gemm g{(const bf16*)(ws + WS_HID), (const bf16*)(ws + WS_W2T1), M_LAT, D, DFF}; pg8::StaticOrder S; S.init(M_LAT, D, G, bx);
        pg8::EpiResidFinal E{XB, args.out, MOD + (size_t)8 * 6 * D + 5 * D, 6 * D, args.in[22], SSQ + 3 * M_LAT, (unsigned*)(ws + WS_PCNT)};
        pg8::gemm_phase<pg8::EpiResidFinal, pg8::StaticOrder, RES_ALIGN, true>(lds, g, S, E);
    }
#undef IN
#undef SEAM
}

#ifndef MK_MODE
#define MK_MODE 0
#endif
extern "C" void kernel_launch(void* const* d_in, const int* in_sizes, int n_in, void* d_out, int out_size, void* d_ws, size_t ws_size, hipStream_t stream) {
    static int grid = 0;
    if (grid == 0) {
        if (n_in != 23 || out_size != M_LAT * D || ws_size < WS_END) { fprintf(stderr, "kernel_launch: unexpected problem shape (n_in %d out %d ws %zu)\n", n_in, out_size, ws_size); grid = -1; return; }
        int dev = 0, cus = 0, per_cu = 0;
        if (hipGetDevice(&dev) != hipSuccess || hipDeviceGetAttribute(&cus, hipDeviceAttributeMultiprocessorCount, dev) != hipSuccess) { grid = -1; return; }
        if (hipFuncSetAttribute((const void*)mk_fwd, hipFuncAttributeMaxDynamicSharedMemorySize, LDS_BYTES) != hipSuccess) { fprintf(stderr, "kernel_launch: hipFuncSetAttribute failed\n"); grid = -1; return; }
        if (hipOccupancyMaxActiveBlocksPerMultiprocessor(&per_cu, (const void*)mk_fwd, NTHR, LDS_BYTES) != hipSuccess || per_cu < 1) { fprintf(stderr, "kernel_launch: occupancy query says %d\n", per_cu); per_cu = 1; }
        (void)hipGetLastError();
        grid = cus;
    }
    if (grid < 0) return;
    (void)hipMemsetAsync((char*)d_ws + WS_CTL, 0, CTL_ZERO_BYTES, stream);
    Args a{};
    for (int i = 0; i < 23; ++i) a.in[i] = (const float*)d_in[i];
    a.out = (float*)d_out; a.ws = (unsigned char*)d_ws;
#if MK_MODE == 0
    for (int p = 0; p < N_PHASES; ++p) { a.ph_lo = p; a.ph_hi = p + 1; a.use_cg = 0; hipLaunchKernelGGL(mk_fwd, dim3(grid), dim3(NTHR), LDS_BYTES, stream, a); }
#else
    a.ph_lo = 0; a.ph_hi = N_PHASES; a.use_cg = (MK_MODE == 1) ? 1 : 0;
    void* kargs[] = {&a};
    hipError_t e = hipLaunchCooperativeKernel((const void*)mk_fwd, dim3(grid), dim3(NTHR), kargs, LDS_BYTES, stream);
    if (e != hipSuccess) fprintf(stderr, "kernel_launch: cooperative launch failed: %s (grid %d)\n", hipGetErrorString(e), grid);
#endif
}
```

```cpp
#include <hip/hip_runtime.h>
#include <hip/hip_cooperative_groups.h>
#include <cstdio>
#include <cstdint>
namespace pg8 {
#define PG8_LAS __attribute__((address_space(3)))
typedef unsigned short bf16_t;
typedef short bf16x8 __attribute__((ext_vector_type(8)));
typedef float f32x4 __attribute__((ext_vector_type(4)));
typedef unsigned u32x4 __attribute__((ext_vector_type(4)));
constexpr int BM = 256, BK = 64, HALF = 128, HTB = HALF * BK * 2  , STAGE_BYTES = 8 * HTB, NXCD = 8, WGM = 8;

__host__ __device__ __forceinline__ int lds_byte(int r, int c) { const int st = (r >> 4) * 2 + (c >> 5), rr = r & 15, cc = c & 31, ob = rr * 64 + cc * 2; return st * 1024 + (ob ^ (((ob >> 9) & 1) << 5)); }
__host__ __device__ __forceinline__ void stage_rc(int b, int& R, int& C) { const int st = b / 1024, sb = b % 1024, swz = sb ^ (((sb >> 9) & 1) << 5); R = (st >> 1) * 16 + swz / 64; C = (st & 1) * 32 + (swz % 64) / 2; }
__host__ __device__ __forceinline__ int perm32(int rho) { const int n = rho >> 4, i = rho & 15; return 8 * (i >> 2) + 4 * n + (i & 3); }

struct Unit { int pm, pn; };
struct Gemm { const bf16_t* A; const bf16_t* Bt; int M, N, K; };

struct StaticOrder {
    int nM, nN, nwg, G, c;
    __host__ __device__ void init(int M, int N, int G_, int c_) { nM = M / BM; nN = N / BM; nwg = nM * nN; G = G_; c = c_; }
    __host__ __device__ bool next(int i, Unit& u) const {
        const long L = (long)i * G + c; if (L >= nwg) return false;
        int wgid = (int)L; { const int q = nwg / NXCD, r = nwg % NXCD, xcd = wgid % NXCD, off = wgid / NXCD; wgid = (xcd < r ? xcd * (q + 1) : r * (q + 1) + (xcd - r) * q) + off; }
        const int nig = WGM * nN, gid = wgid / nig, fm = gid * WGM, gsz = (nM - fm) < WGM ? (nM - fm) : WGM;
        u.pm = fm + ((wgid % nig) % gsz); u.pn = (wgid % nig) / gsz; return true;
    }
    __device__ __forceinline__ void a_ready(const Unit&) const {}
    __device__ __forceinline__ void done(const Unit&) const {}
};

__device__ __forceinline__ unsigned cvt_pk_bf16(float lo, float hi) { unsigned r; asm volatile("v_cvt_pk_bf16_f32 %0, %1, %2" : "=v"(r) : "v"(lo), "v"(hi)); return r; }
typedef float f32x2 __attribute__((ext_vector_type(2)));
constexpr float NA_C2 = 0.125f * 1.4426950408889634f;
#ifndef EPI_WT
#define EPI_WT 1
#endif
__device__ __forceinline__ void st16(void* p, u32x4 v) {
#if EPI_WT
    asm volatile("global_store_dwordx4 %0, %1, off sc1\n\ts_nop 1" :: "v"(p), "v"(v) : "memory");
#else
    *(u32x4*)p = v;
#endif
}
__device__ __forceinline__ void st16f(float* p, f32x4 v) { st16((void*)p, __builtin_bit_cast(u32x4, v)); }
__device__ __forceinline__ void st8(void* p, unsigned lo, unsigned hi) {
#if EPI_WT
    typedef unsigned u32x2_ __attribute__((ext_vector_type(2))); const u32x2_ v = {lo, hi};
    asm volatile("global_store_dwordx2 %0, %1, off sc1" :: "v"(p), "v"(v) : "memory");
#else
    typedef unsigned u32x2_ __attribute__((ext_vector_type(2))); *(u32x2_*)p = (u32x2_){lo, hi};
#endif
}
__device__ __forceinline__ u32x4 pack8(f32x4 v0, f32x4 v1) { u32x4 w; w.x = cvt_pk_bf16(v0[0], v0[1]); w.y = cvt_pk_bf16(v0[2], v0[3]); w.z = cvt_pk_bf16(v1[0], v1[1]); w.w = cvt_pk_bf16(v1[2], v1[3]); return w; }

struct EpiNoPre {};
struct EpiInProj {
    static constexpr bool PERM = true, AFTER_DRAIN = false; typedef EpiNoPre Pre;
    __device__ __forceinline__ void pre(Pre&, const Unit&, int, int, int, int) const {}
    bf16_t* xbc; bf16_t* zq; bf16_t* kv; float* dtraw;
    __device__ __forceinline__ void operator()(const f32x4 (&acc)[2][2][4][2], const Unit& u, int wr, int wc, int fr, int fq, const Pre&) const {
        const int row0 = u.pm * BM + wr * 64 + fr; const int pn = u.pn;
        if (pn == 22) {
            if (wc == 0) {
#pragma unroll
                for (int ai = 0; ai < 2; ++ai)
#pragma unroll
                    for (int m = 0; m < 4; ++m) { float* rp = dtraw + (size_t)(row0 + ai * HALF + m * 16) * 32 + 8 * fq;
                        *(f32x4*)rp = acc[ai][0][m][0]; *(f32x4*)(rp + 4) = acc[ai][0][m][1]; }
            }
            return;
        }
        bf16_t* base; int ldc, colt; float sc = 1.f;
        if (pn < 6) { base = xbc; ldc = 1536; colt = pn * 256; }
        else if (pn < 14) { base = zq; ldc = 2048; colt = (pn - 6) * 256; if (pn >= 10) sc = NA_C2; }
        else { base = kv; ldc = 2048; colt = (pn - 14) * 256; }
        const int col0 = colt + wc * 32 + 8 * fq;
#pragma unroll
        for (int ai = 0; ai < 2; ++ai)
#pragma unroll
            for (int m = 0; m < 4; ++m) { bf16_t* rowp = base + (size_t)(row0 + ai * HALF + m * 16) * ldc + col0;
#pragma unroll
                for (int bj = 0; bj < 2; ++bj) st16(rowp + bj * HALF, pack8(acc[ai][bj][m][0] * sc, acc[ai][bj][m][1] * sc)); }
    }
};
template <int ACT, bool NORM> struct EpiBf16Act {
    static constexpr bool PERM = true, AFTER_DRAIN = false;
    bf16_t* O; int ldc; const float* ss; const float* biasb; int bstride;
    struct Pre { };
    __device__ __forceinline__ void pre(Pre& p, const Unit& u, int wr, int wc, int fr, int fq) const {
        if (NORM) {
            const int row0 = u.pm * BM + wr * 64 + fr, col0 = u.pn * BM + wc * 32 + 8 * fq;
            (void)row0; (void)col0; (void)p;
        }
    }
    __device__ __forceinline__ void operator()(const f32x4 (&acc)[2][2][4][2], const Unit& u, int wr, int wc, int fr, int fq, const Pre& p) const {
        const int row0 = u.pm * BM + wr * 64 + fr, col0 = u.pn * BM + wc * 32 + 8 * fq;
        float rs[2][4]; f32x4 bv[2][2];
        if (NORM) {
            const float* bp = biasb + (size_t)(u.pm >> 4) * bstride + col0;
#pragma unroll
            for (int bj = 0; bj < 2; ++bj) { bv[bj][0] = *(const f32x4*)(bp + bj * HALF); bv[bj][1] = *(const f32x4*)(bp + bj * HALF + 4); }
#pragma unroll
            for (int ai = 0; ai < 2; ++ai)
#pragma unroll
                for (int m = 0; m < 4; ++m) rs[ai][m] = __builtin_amdgcn_rsqf(ss[row0 + ai * HALF + m * 16] * (1.f / 1024.f) + 1e-6f);
        }
#pragma unroll
        for (int ai = 0; ai < 2; ++ai)
#pragma unroll
            for (int m = 0; m < 4; ++m) { bf16_t* rowp = O + (size_t)(row0 + ai * HALF + m * 16) * ldc + col0;
#pragma unroll
                for (int bj = 0; bj < 2; ++bj) { f32x4 v0 = acc[ai][bj][m][0], v1 = acc[ai][bj][m][1];
                    if (NORM) { v0 = v0 * rs[ai][m] + bv[bj][0]; v1 = v1 * rs[ai][m] + bv[bj][1]; }
                    if (ACT == 1) { v0 = __builtin_elementwise_max(v0, (f32x4){0.f, 0.f, 0.f, 0.f}); v1 = __builtin_elementwise_max(v1, (f32x4){0.f, 0.f, 0.f, 0.f}); v0 = v0 * v0; v1 = v1 * v1; }
                    st16(rowp + bj * HALF, pack8(v0, v1)); } }
    }
};
struct EpiScIn {
    static constexpr bool PERM = true, AFTER_DRAIN = false; typedef EpiNoPre Pre;
    __device__ __forceinline__ void pre(Pre&, const Unit&, int, int, int, int) const {}
    bf16_t* O; const float* ss; const float* biasb; int bstride;
    __device__ __forceinline__ void operator()(const f32x4 (&acc)[2][2][4][2], const Unit& u, int wr, int wc, int fr, int fq, const Pre&) const {
        const int row0 = u.pm * BM + wr * 64 + fr, col0 = u.pn * BM + wc * 32 + 8 * fq;
        float rs[2][4]; f32x4 bv[2][2];
        const float* bp = biasb + (size_t)(u.pm >> 4) * bstride + col0;
#pragma unroll
        for (int bj = 0; bj < 2; ++bj) { bv[bj][0] = *(const f32x4*)(bp + bj * HALF); bv[bj][1] = *(const f32x4*)(bp + bj * HALF + 4); }
#pragma unroll
        for (int ai = 0; ai < 2; ++ai)
#pragma unroll
            for (int m = 0; m < 4; ++m) rs[ai][m] = __builtin_amdgcn_rsqf(ss[row0 + ai * HALF + m * 16] * (1.f / 1024.f) + 1e-6f);
        if (u.pn < 4) {
#pragma unroll
            for (int ai = 0; ai < 2; ++ai)
#pragma unroll
                for (int m = 0; m < 4; ++m) { bf16_t* rowp = O + (size_t)(row0 + ai * HALF + m * 16) * 2048 + col0;
#pragma unroll
                    for (int bj = 0; bj < 2; ++bj) st16(rowp + bj * HALF, pack8(acc[ai][bj][m][0] * rs[ai][m] + bv[bj][0], acc[ai][bj][m][1] * rs[ai][m] + bv[bj][1])); }
        } else {
            const int ucol = 1024 + (u.pn - 4) * HALF + wc * 32 + 8 * fq;
#pragma unroll
            for (int ai = 0; ai < 2; ++ai)
#pragma unroll
                for (int m = 0; m < 4; ++m) { bf16_t* rowp = O + (size_t)(row0 + ai * HALF + m * 16) * 2048 + ucol;
                    const f32x4 c0 = acc[ai][0][m][0] * rs[ai][m] + bv[0][0], c1 = acc[ai][0][m][1] * rs[ai][m] + bv[0][1];
                    const f32x4 v0 = acc[ai][1][m][0] * rs[ai][m] + bv[1][0], v1 = acc[ai][1][m][1] * rs[ai][m] + bv[1][1];
                    st16(rowp, pack8(c0 * v0, c1 * v1)); }
        }
    }
};
template <int STMODE> struct EpiProbeAct {
    static constexpr bool PERM = true, AFTER_DRAIN = false; typedef EpiNoPre Pre;
    __device__ __forceinline__ void pre(Pre&, const Unit&, int, int, int, int) const {}
    bf16_t* O; int ldc; const float* ss; const float* biasb; int bstride;
    __device__ __forceinline__ void operator()(const f32x4 (&acc)[2][2][4][2], const Unit& u, int wr, int wc, int fr, int fq, const Pre&) const {
        const int row0 = u.pm * BM + wr * 64 + fr, col0 = u.pn * BM + wc * 32 + 8 * fq;
        float rs[2][4]; f32x4 bv[2][2];
        const float* bp = biasb + (size_t)(u.pm >> 4) * bstride + col0;
#pragma unroll
        for (int bj = 0; bj < 2; ++bj) { bv[bj][0] = *(const f32x4*)(bp + bj * HALF); bv[bj][1] = *(const f32x4*)(bp + bj * HALF + 4); }
#pragma unroll
        for (int ai = 0; ai < 2; ++ai)
#pragma unroll
            for (int m = 0; m < 4; ++m) rs[ai][m] = __builtin_amdgcn_rsqf(ss[row0 + ai * HALF + m * 16] * (1.f / 1024.f) + 1e-6f);
#pragma unroll
        for (int ai = 0; ai < 2; ++ai)
#pragma unroll
            for (int m = 0; m < 4; ++m) {
                bf16_t* rowp = (STMODE == 1) ? O + (size_t)(((u.pm & 1) * 8 + ai * 4 + m) * 16 + fr) * 256 + wc * 32 + 8 * fq
                                             : O + (size_t)(row0 + ai * HALF + m * 16) * ldc + col0;
#pragma unroll
                for (int bj = 0; bj < 2; ++bj) { f32x4 v0 = acc[ai][bj][m][0] * rs[ai][m] + bv[bj][0], v1 = acc[ai][bj][m][1] * rs[ai][m] + bv[bj][1];
                    v0 = __builtin_elementwise_max(v0, (f32x4){0.f, 0.f, 0.f, 0.f}); v1 = __builtin_elementwise_max(v1, (f32x4){0.f, 0.f, 0.f, 0.f}); v0 = v0 * v0; v1 = v1 * v1;
                    const u32x4 pk = pack8(v0, v1);
                    if (STMODE == 1 || (pk.x == 0x12345678u && pk.w == 0x9abcdef0u)) *(u32x4*)(rowp + bj * HALF) = pk; } }
    }
};
struct EpiNull {
    static constexpr bool PERM = true, AFTER_DRAIN = false; typedef EpiNoPre Pre;
    __device__ __forceinline__ void pre(Pre&, const Unit&, int, int, int, int) const {}
    float* sink;
    __device__ __forceinline__ void operator()(const f32x4 (&acc)[2][2][4][2], const Unit& u, int wr, int wc, int fr, int fq, const Pre&) const {
        float s = 0.f;
#pragma unroll
        for (int ai = 0; ai < 2; ++ai)
#pragma unroll
            for (int bj = 0; bj < 2; ++bj)
#pragma unroll
                for (int m = 0; m < 4; ++m)
#pragma unroll
                    for (int n = 0; n < 2; ++n) s += (acc[ai][bj][m][n][0] + acc[ai][bj][m][n][1]) + (acc[ai][bj][m][n][2] + acc[ai][bj][m][n][3]);
        if (s == 123456.789f) sink[u.pm * 7 + u.pn + wr + wc + fr + fq] = s;
    }
};
template <bool NEXT, bool RIN_F32> struct EpiResid {
    static constexpr bool PERM = true, AFTER_DRAIN = false; typedef EpiNoPre Pre;
    __device__ __forceinline__ void pre(Pre&, const Unit&, int, int, int, int) const {}
    const void* resid; bf16_t* out; const float* gate; int gstride; bf16_t* an; const float* wsv; float* ssq;
    __device__ __forceinline__ void operator()(const f32x4 (&acc)[2][2][4][2], const Unit& u, int wr, int wc, int fr, int fq, const Pre&) const {
        const int row0 = u.pm * BM + wr * 64 + fr, col0 = u.pn * BM + wc * 32 + 8 * fq;
        const float* gp = gate + (size_t)(u.pm >> 4) * gstride + col0;
        f32x4 gv[2][2], wv[2][2];
#pragma unroll
        for (int bj = 0; bj < 2; ++bj)
#pragma unroll
            for (int n = 0; n < 2; ++n) { gv[bj][n] = *(const f32x4*)(gp + bj * HALF + n * 4); if (NEXT) wv[bj][n] = *(const f32x4*)(wsv + (size_t)(u.pm >> 4) * 1024 + col0 + bj * HALF + n * 4); }
        constexpr int NB = RIN_F32 ? 4 : 2, MB = RIN_F32 ? 2 : 4;
#pragma unroll
        for (int bt = 0; bt < NB; ++bt) { const int ai = RIN_F32 ? (bt >> 1) : bt, mb = RIN_F32 ? 2 * (bt & 1) : 0;
            f32x4 rr[RIN_F32 ? MB : 1][2][2]; u32x4 rq[RIN_F32 ? 1 : MB][2];
#pragma unroll
            for (int m2 = 0; m2 < MB; ++m2) { const size_t off = (size_t)(row0 + ai * HALF + (mb + m2) * 16) * 1024 + col0;
#pragma unroll
                for (int bj = 0; bj < 2; ++bj) {
                    if (RIN_F32) { rr[RIN_F32 ? m2 : 0][bj][0] = *(const f32x4*)((const float*)resid + off + bj * HALF); rr[RIN_F32 ? m2 : 0][bj][1] = *(const f32x4*)((const float*)resid + off + bj * HALF + 4); }
                    else rq[RIN_F32 ? 0 : m2][bj] = *(const u32x4*)((const bf16_t*)resid + off + bj * HALF); } }
            asm volatile("" ::: "memory");
#pragma unroll
            for (int m2 = 0; m2 < MB; ++m2) { const int m = mb + m2; const int row = row0 + ai * HALF + m * 16; const size_t off = (size_t)row * 1024 + col0; float sq = 0.f;
#pragma unroll
                for (int bj = 0; bj < 2; ++bj) {
                    f32x4 r0, r1;
                    if (RIN_F32) { r0 = rr[RIN_F32 ? m2 : 0][bj][0]; r1 = rr[RIN_F32 ? m2 : 0][bj][1]; }
                    else { const u32x4 q = rq[RIN_F32 ? 0 : m2][bj];
                        r0 = (f32x4){__uint_as_float(q.x << 16), __uint_as_float(q.x & 0xffff0000u), __uint_as_float(q.y << 16), __uint_as_float(q.y & 0xffff0000u)};
                        r1 = (f32x4){__uint_as_float(q.z << 16), __uint_as_float(q.z & 0xffff0000u), __uint_as_float(q.w << 16), __uint_as_float(q.w & 0xffff0000u)}; }
                    const f32x4 o0 = r0 + gv[bj][0] * acc[ai][bj][m][0], o1 = r1 + gv[bj][1] * acc[ai][bj][m][1];
                    *(u32x4*)(out + off + bj * HALF) = pack8(o0, o1);
                    if (NEXT) { sq += ((o0[0] * o0[0] + o0[1] * o0[1]) + (o0[2] * o0[2] + o0[3] * o0[3])) + ((o1[0] * o1[0] + o1[1] * o1[1]) + (o1[2] * o1[2] + o1[3] * o1[3]));
                        *(u32x4*)(an + off + bj * HALF) = pack8(o0 * wv[bj][0], o1 * wv[bj][1]); } }
                if (NEXT) { sq += __shfl_xor(sq, 16); sq += __shfl_xor(sq, 32); if (fq == 0) atomicAdd(ssq + row, sq); } }
        }
    }
};
struct EpiResidFinal {
    static constexpr bool PERM = true, AFTER_DRAIN = false; typedef EpiNoPre Pre;
    __device__ __forceinline__ void pre(Pre&, const Unit&, int, int, int, int) const {}
    const bf16_t* resid; float* out; const float* gate; int gstride; const float* nw; float* ssq; unsigned* cnt;
    __device__ __forceinline__ void operator()(f32x4 (&acc)[2][2][4][2], const Unit& u, int wr, int wc, int fr, int fq, const Pre&) const {
        const int row0 = u.pm * BM + wr * 64 + fr, col0 = u.pn * BM + wc * 32 + 8 * fq;
        const float* gp = gate + (size_t)(u.pm >> 4) * gstride + col0;
        f32x4 gv[2][2];
#pragma unroll
        for (int bj = 0; bj < 2; ++bj)
#pragma unroll
            for (int n = 0; n < 2; ++n) gv[bj][n] = *(const f32x4*)(gp + bj * HALF + n * 4);
        float part[2][4];
#pragma unroll
        for (int ai = 0; ai < 2; ++ai) {
            u32x4 rq[4][2];
#pragma unroll
            for (int m = 0; m < 4; ++m) { const size_t off = (size_t)(row0 + ai * HALF + m * 16) * 1024 + col0;
#pragma unroll
                for (int bj = 0; bj < 2; ++bj) rq[m][bj] = *(const u32x4*)(resid + off + bj * HALF); }
#pragma unroll
            for (int m = 0; m < 4; ++m) { float sq = 0.f;
#pragma unroll
                for (int bj = 0; bj < 2; ++bj) { const u32x4 q = rq[m][bj];
                    const f32x4 r0 = (f32x4){__uint_as_float(q.x << 16), __uint_as_float(q.x & 0xffff0000u), __uint_as_float(q.y << 16), __uint_as_float(q.y & 0xffff0000u)};
                    const f32x4 r1 = (f32x4){__uint_as_float(q.z << 16), __uint_as_float(q.z & 0xffff0000u), __uint_as_float(q.w << 16), __uint_as_float(q.w & 0xffff0000u)};
                    const f32x4 o0 = r0 + gv[bj][0] * acc[ai][bj][m][0], o1 = r1 + gv[bj][1] * acc[ai][bj][m][1]; acc[ai][bj][m][0] = o0; acc[ai][bj][m][1] = o1;
                    sq += ((o0[0] * o0[0] + o0[1] * o0[1]) + (o0[2] * o0[2] + o0[3] * o0[3])) + ((o1[0] * o1[0] + o1[1] * o1[1]) + (o1[2] * o1[2] + o1[3] * o1[3])); }
                sq += __shfl_xor(sq, 16); sq += __shfl_xor(sq, 32); part[ai][m] = sq; } }
        float got = 0.f;
        if (fq == 0) {
#pragma unroll
            for (int ai = 0; ai < 2; ++ai)
#pragma unroll
                for (int m = 0; m < 4; ++m) got += __hip_atomic_fetch_add(ssq + row0 + ai * HALF + m * 16, part[ai][m], __ATOMIC_RELAXED, __HIP_MEMORY_SCOPE_AGENT);
        }
        asm volatile("s_waitcnt vmcnt(0)" : "+v"(got) :: "memory");
        unsigned* cw = cnt + 64 * u.pm;
        if ((threadIdx.x & 63) == 0) __hip_atomic_fetch_add(cw, 1u, __ATOMIC_RELAXED, __HIP_MEMORY_SCOPE_AGENT);
        { unsigned spins = 0;
          while ((unsigned)__builtin_amdgcn_readfirstlane((int)__hip_atomic_load(cw, __ATOMIC_RELAXED, __HIP_MEMORY_SCOPE_AGENT)) < 32u) { __builtin_amdgcn_s_sleep(4); if (++spins > (1u << 20)) break; } }
        asm volatile("s_waitcnt vmcnt(0)" ::: "memory");
        float rs[2][4];
#pragma unroll
        for (int ai = 0; ai < 2; ++ai)
#pragma unroll
            for (int m = 0; m < 4; ++m) rs[ai][m] = __builtin_amdgcn_rsqf(__hip_atomic_load(ssq + row0 + ai * HALF + m * 16, __ATOMIC_RELAXED, __HIP_MEMORY_SCOPE_AGENT) * (1.f / 1024.f) + 1e-6f);
        f32x4 wv[2][2];
#pragma unroll
        for (int bj = 0; bj < 2; ++bj)
#pragma unroll
            for (int n = 0; n < 2; ++n) wv[bj][n] = *(const f32x4*)(nw + col0 + bj * HALF + n * 4);
#pragma unroll
        for (int ai = 0; ai < 2; ++ai)
#pragma unroll
            for (int m = 0; m < 4; ++m) { const size_t off = (size_t)(row0 + ai * HALF + m * 16) * 1024 + col0;
#pragma unroll
                for (int bj = 0; bj < 2; ++bj)
#pragma unroll
                    for (int n = 0; n < 2; ++n) *(f32x4*)(out + off + bj * HALF + n * 4) = acc[ai][bj][m][n] * rs[ai][m] * wv[bj][n]; }
    }
};
struct InProjOrder {
    int G, c;
    __device__ __forceinline__ bool next(int i, Unit& u) const {
        constexpr int nM = 128, nN = 23, nwg = nM * nN;
        const long L = (long)i * G + c;
        if (L < nwg) {
            int wgid = (int)L; { const int q = nwg / NXCD, r = nwg % NXCD, xcd = wgid % NXCD, off = wgid / NXCD; wgid = (xcd < r ? xcd * (q + 1) : r * (q + 1) + (xcd - r) * q) + off; }
            const int nig = WGM * nN, gid = wgid / nig, fm = gid * WGM, gsz = (nM - fm) < WGM ? (nM - fm) : WGM;
            u.pm = fm + ((wgid % nig) % gsz); u.pn = (wgid % nig) / gsz; return true;
        }
        const int idx = (int)(L - nwg); if (idx >= 112) return false;
        const int j = idx >> 3; u.pm = 128 + (idx & 7); u.pn = j < 5 ? j : (j < 13 ? 9 + j : 22); return true;
    }
    __device__ __forceinline__ void a_ready(const Unit&) const {}
    __device__ __forceinline__ void done(const Unit&) const {}
};
template <class Epi, class Sched, bool ALIGN_EPI = false, bool SP2 = false>
__device__ __forceinline__ void gemm_phase(PG8_LAS unsigned char* lds, const Gemm g, const Sched& S, const Epi& E) {
    const int tid = threadIdx.x, wid = __builtin_amdgcn_readfirstlane(tid >> 6), lane = tid & 63, wr = wid >> 2, wc = wid & 3, fr = lane & 15, fq = lane >> 4;
    const int K = g.K, nt = K / BK;
    unsigned voffA[2], voffB[2];
#pragma unroll
    for (int i = 0; i < 2; ++i) { int R, C; stage_rc(tid * 16 + i * 8192, R, C); const int Rb = Epi::PERM ? ((R & ~31) + perm32(R & 31)) : R;
        voffA[i] = (unsigned)(R * K + C) * 2u; voffB[i] = (unsigned)(Rb * K + C) * 2u; }
    const size_t kstep = (size_t)(BK * 2);
    const size_t hstep = (size_t)HALF * K * 2;
    const size_t tstep = 2 * hstep;
    const unsigned ldsw = (unsigned)wid * 1024u;
    const int aoff = lds_byte(wr * 64 + fr, fq * 8), boff = lds_byte(wc * 32 + fr, fq * 8);
#define PG8_SA(b, h) (((b) * 2 + (h)) * HTB)
#define PG8_SB(b, h) ((4 + (b) * 2 + (h)) * HTB)
#define PG8_STAGE(bufoff, gbase, voff) do { _Pragma("unroll") for (int _i = 0; _i < 2; ++_i) \
        __builtin_amdgcn_global_load_lds((const unsigned*)((const char*)(gbase) + (voff)[_i]), (PG8_LAS unsigned*)(lds + (bufoff) + ldsw + _i * 8192), 16, 0, 0); } while (0)
#define PG8_LDA(dst, b, h) do { _Pragma("unroll") for (int m = 0; m < 4; ++m) _Pragma("unroll") for (int k = 0; k < 2; ++k) dst[m][k] = *(const PG8_LAS bf16x8*)(lds + PG8_SA(b, h) + aoff + m * 2048 + k * 1024); } while (0)
#define PG8_LDB(dst, b, h) do { _Pragma("unroll") for (int n = 0; n < 2; ++n) _Pragma("unroll") for (int k = 0; k < 2; ++k) dst[n][k] = *(const PG8_LAS bf16x8*)(lds + PG8_SB(b, h) + boff + n * 2048 + k * 1024); } while (0)
#define PG8_MMA(ai, bj, At, Bt) do { __builtin_amdgcn_s_setprio(1); _Pragma("unroll") for (int m = 0; m < 4; ++m) _Pragma("unroll") for (int n = 0; n < 2; ++n) _Pragma("unroll") for (int k = 0; k < 2; ++k) \
        acc[ai][bj][m][n] = __builtin_amdgcn_mfma_f32_16x16x32_bf16(Bt[n][k], At[m][k], acc[ai][bj][m][n], 0, 0, 0); __builtin_amdgcn_s_setprio(0); } while (0)
#define PG8_WAIT_V(n) asm volatile("s_waitcnt vmcnt(" #n ")" ::: "memory")
#define PG8_WAIT_L(n) asm volatile("s_waitcnt lgkmcnt(" #n ")" ::: "memory")
#define PG8_BAR __builtin_amdgcn_s_barrier()
#define PG8_SCHED __builtin_amdgcn_sched_barrier(0)
    Unit cur, nxt; int ui = 0;
    if (!S.next(0, cur)) return;
    f32x4 acc[2][2][4][2];
#pragma unroll
    for (int a = 0; a < 2; ++a)
#pragma unroll
        for (int b = 0; b < 2; ++b)
#pragma unroll
            for (int m = 0; m < 4; ++m)
#pragma unroll
                for (int n = 0; n < 2; ++n) acc[a][b][m][n] = (f32x4){0.f, 0.f, 0.f, 0.f};
    bf16x8 At[4][2], B0[2][2], B1[2][2];
    const char* cA = (const char*)g.A + (size_t)cur.pm * tstep; const char* cB = (const char*)g.Bt + (size_t)cur.pn * tstep;
    S.a_ready(cur);
    typename Epi::Pre epre; E.pre(epre, cur, wr, wc, fr, fq);
    if constexpr (SP2) {
        PG8_STAGE(PG8_SB(0, 0), cB, voffB); PG8_STAGE(PG8_SB(0, 1), cB + hstep, voffB); PG8_STAGE(PG8_SA(0, 0), cA, voffA); PG8_STAGE(PG8_SA(0, 1), cA + hstep, voffA);
        if (wr == 1) PG8_BAR;
        PG8_WAIT_V(2); PG8_BAR;
        PG8_STAGE(PG8_SB(1, 0), cB + kstep, voffB); PG8_STAGE(PG8_SA(1, 0), cA + kstep, voffA); PG8_STAGE(PG8_SB(1, 1), cB + hstep + kstep, voffB);
        PG8_WAIT_V(6); PG8_BAR;
    } else {
        PG8_STAGE(PG8_SB(0, 0), cB, voffB); PG8_STAGE(PG8_SA(0, 0), cA, voffA); PG8_STAGE(PG8_SB(0, 1), cB + hstep, voffB); PG8_STAGE(PG8_SA(0, 1), cA + hstep, voffA);
        if (wr == 1) PG8_BAR;
        PG8_WAIT_V(4); PG8_BAR;
        PG8_STAGE(PG8_SB(1, 0), cB + kstep, voffB); PG8_STAGE(PG8_SA(1, 0), cA + kstep, voffA); PG8_STAGE(PG8_SB(1, 1), cB + hstep + kstep, voffB);
        PG8_WAIT_V(6); PG8_BAR;
    }
    for (;;) {
        const bool has_next = S.next(ui + 1, nxt);
        const char* nA = has_next ? (const char*)g.A + (size_t)nxt.pm * tstep : cA; const char* nB = has_next ? (const char*)g.Bt + (size_t)nxt.pn * tstep : cB;
        for (int t = 0; t < nt; t += 2) {
            const bool last = (t == nt - 2);
            const char* a1 = cA + (size_t)(t + 1) * kstep;
            const char* a2 = last ? nA : cA + (size_t)(t + 2) * kstep; const char* b2 = last ? nB : cB + (size_t)(t + 2) * kstep;
            const char* a3 = a2 + kstep; const char* b3 = b2 + kstep;
            if (last && has_next) S.a_ready(nxt);
            if constexpr (SP2) {
            PG8_LDB(B0, 0, 0); PG8_LDB(B1, 0, 1); PG8_SCHED; PG8_LDA(At, 0, 0); PG8_STAGE(PG8_SA(1, 1), a1 + hstep, voffA);
            PG8_WAIT_V(8); PG8_WAIT_L(0); PG8_BAR; PG8_MMA(0, 0, At, B0); PG8_MMA(0, 1, At, B1); PG8_BAR; PG8_SCHED;
            PG8_LDA(At, 0, 1); PG8_STAGE(PG8_SB(0, 0), b2, voffB); PG8_STAGE(PG8_SB(0, 1), b2 + hstep, voffB); PG8_STAGE(PG8_SA(0, 0), a2, voffA);
            PG8_WAIT_V(8); PG8_WAIT_L(0); PG8_BAR; PG8_MMA(1, 0, At, B0); PG8_MMA(1, 1, At, B1); PG8_BAR; PG8_SCHED;
            PG8_LDB(B0, 1, 0); PG8_LDB(B1, 1, 1); PG8_SCHED; PG8_LDA(At, 1, 0); PG8_STAGE(PG8_SA(0, 1), a2 + hstep, voffA);
            PG8_WAIT_V(8); PG8_WAIT_L(0); PG8_BAR; PG8_MMA(0, 0, At, B0); PG8_MMA(0, 1, At, B1); PG8_BAR; PG8_SCHED;
            PG8_LDA(At, 1, 1); PG8_STAGE(PG8_SB(1, 0), b3, voffB); PG8_STAGE(PG8_SB(1, 1), b3 + hstep, voffB); PG8_STAGE(PG8_SA(1, 0), a3, voffA);
            PG8_WAIT_V(8); PG8_WAIT_L(0); PG8_BAR; PG8_MMA(1, 0, At, B0); PG8_MMA(1, 1, At, B1); PG8_BAR; PG8_SCHED;
            } else {
            PG8_LDB(B0, 0, 0); PG8_SCHED; PG8_LDA(At, 0, 0); PG8_STAGE(PG8_SA(1, 1), a1 + hstep, voffA);
            PG8_WAIT_L(8); PG8_BAR; PG8_WAIT_L(0); PG8_MMA(0, 0, At, B0); PG8_BAR; PG8_SCHED;
            PG8_LDB(B1, 0, 1); PG8_STAGE(PG8_SB(0, 0), b2, voffB);
            PG8_BAR; PG8_WAIT_L(0); PG8_MMA(0, 1, At, B1); PG8_BAR;
            PG8_LDA(At, 0, 1); PG8_STAGE(PG8_SA(0, 0), a2, voffA);
            PG8_BAR; PG8_WAIT_L(0); PG8_MMA(1, 0, At, B0); PG8_BAR; PG8_SCHED;
            PG8_STAGE(PG8_SB(0, 1), b2 + hstep, voffB);
            PG8_WAIT_V(6); PG8_BAR; PG8_MMA(1, 1, At, B1); PG8_BAR;
            PG8_LDB(B0, 1, 0); PG8_SCHED; PG8_LDA(At, 1, 0); PG8_STAGE(PG8_SA(0, 1), a2 + hstep, voffA);
            PG8_WAIT_L(8); PG8_BAR; PG8_WAIT_L(0); PG8_MMA(0, 0, At, B0); PG8_BAR; PG8_SCHED;
            PG8_LDB(B1, 1, 1); PG8_STAGE(PG8_SB(1, 0), b3, voffB);
            PG8_BAR; PG8_WAIT_L(0); PG8_MMA(0, 1, At, B1); PG8_BAR;
            PG8_LDA(At, 1, 1); PG8_STAGE(PG8_SA(1, 0), a3, voffA);
            PG8_BAR; PG8_WAIT_L(0); PG8_MMA(1, 0, At, B0); PG8_BAR; PG8_SCHED;
            PG8_STAGE(PG8_SB(1, 1), b3 + hstep, voffB);
            PG8_WAIT_V(6); PG8_BAR; PG8_MMA(1, 1, At, B1); PG8_BAR;
            }
        }
        if constexpr (ALIGN_EPI) { if (wr == 0) PG8_BAR; }
        if constexpr (!Epi::AFTER_DRAIN) { E(acc, cur, wr, wc, fr, fq, epre); S.done(cur); }
        if (!has_next) break;
#pragma unroll
        for (int a = 0; a < 2; ++a)
#pragma unroll
            for (int b = 0; b < 2; ++b)
#pragma unroll
                for (int m = 0; m < 4; ++m)
#pragma unroll
                    for (int n = 0; n < 2; ++n) acc[a][b][m][n] = (f32x4){0.f, 0.f, 0.f, 0.f};
        cur = nxt; cA = nA; cB = nB; ++ui; E.pre(epre, cur, wr, wc, fr, fq);
        if constexpr (ALIGN_EPI) { if (wr == 1) PG8_BAR; }
    }
    PG8_WAIT_V(0);
    if constexpr (!ALIGN_EPI) { if (wr == 0) PG8_BAR; }
    PG8_BAR;
    if constexpr (Epi::AFTER_DRAIN) { E.fused(acc, cur, wr, wc, fr, fq, lds, wid, lane); S.done(cur); }
#undef PG8_SA
#undef PG8_SB
#undef PG8_STAGE
#undef PG8_LDA
#undef PG8_LDB
#undef PG8_MMA
#undef PG8_WAIT_V
#undef PG8_WAIT_L
#undef PG8_BAR
#undef PG8_SCHED
}
}
#define GAS __attribute__((address_space(1)))
#define LAS __attribute__((address_space(3)))
typedef unsigned short bf16;
typedef unsigned v4u __attribute__((ext_vector_type(4)));
typedef float f32x4 __attribute__((ext_vector_type(4)));
typedef short bf16x8 __attribute__((ext_vector_type(8)));
typedef GAS unsigned gu32;
typedef GAS unsigned long long gu64;
#define RLX_AGENT __ATOMIC_RELAXED, __HIP_MEMORY_SCOPE_AGENT
#define LDS_WAIT() asm volatile("s_waitcnt lgkmcnt(0)" ::: "memory")
#define VM_WAIT() asm volatile("s_waitcnt vmcnt(0)" ::: "memory")
__device__ __forceinline__ unsigned long long rt() { return __builtin_amdgcn_s_memrealtime(); }
__device__ __forceinline__ unsigned f2bf(float f) { unsigned u = __builtin_bit_cast(unsigned, f); return (u + 0x7fffu + ((u >> 16) & 1u)) >> 16; }
__device__ __forceinline__ unsigned pk2(float lo, float hi) { return f2bf(lo) | (f2bf(hi) << 16); }

__device__ __forceinline__ float wave_sum(float v) {
#pragma unroll
    for (int o = 1; o < 64; o <<= 1) v += __shfl_xor(v, o);
    return v;
}
#define XB_TMO      128
#define XB_XCNT(j)  (256  + 64 * (j))
#define XB_XSUB(j)  (1280 + 64 * (j))
#define XB_XGEN(j)  (2304 + 64 * (j))
#define XB_TOP      3328
#define XB_TOPGEN   3392
#define XCD_BAR_WORDS 3456
#define XB_SPIN_CAP (1u << 18)

__device__ __forceinline__ unsigned xb_ld(unsigned* p)              { return __hip_atomic_load(p, __ATOMIC_RELAXED, __HIP_MEMORY_SCOPE_AGENT); }
__device__ __forceinline__ unsigned xb_add(unsigned* p, unsigned v) { return __hip_atomic_fetch_add(p, v, __ATOMIC_RELAXED, __HIP_MEMORY_SCOPE_AGENT); }
__device__ __forceinline__ unsigned xb_xcc_id() { return (unsigned)__builtin_amdgcn_s_getreg((3 << 11) | 20) & 0xFu; }
#define XB_SPIN(cond, bar) do { unsigned _sp = 0; while (cond) { __builtin_amdgcn_s_sleep(1); \
    if ((++_sp & 255u) == 0u) { if (xb_ld(&(bar)[XB_TMO])) break; if (_sp > XB_SPIN_CAP) { atomicAdd(&(bar)[XB_TMO], 1u); break; } } } } while (0)

struct XcdBarrier {
    unsigned* bar; unsigned x;
    volatile LAS unsigned* st;
};

__device__ __forceinline__ XcdBarrier xcd_barrier_post(unsigned* bar, volatile LAS unsigned* st) {
    XcdBarrier b; b.bar = bar; b.x = xb_xcc_id(); b.st = st;
    if (threadIdx.x == 0) (void)xb_add(&bar[XB_XCNT(b.x)], 1u);
    return b;
}
__device__ __forceinline__ void xcd_barrier_complete(unsigned* bar, unsigned x, unsigned& nloc, unsigned& nx) {
    const unsigned G = gridDim.x * gridDim.y * gridDim.z;
    unsigned sum, cnt, mine, sp = 0u;
    for (;;) {
        sum = 0u; cnt = 0u; mine = 0u;
#pragma unroll
        for (unsigned j = 0; j < 16; ++j) { const unsigned c = xb_ld(&bar[XB_XCNT(j)]); sum += c; cnt += (c > 0u) ? 1u : 0u; mine = (j == x) ? c : mine; }
        if (sum == G) break;
        __builtin_amdgcn_s_sleep(1);
        if ((++sp & 255u) == 0u) { if (xb_ld(&bar[XB_TMO])) break; if (sp > XB_SPIN_CAP) { atomicAdd(&bar[XB_TMO], 1u); break; } }
    }
    nloc = mine > 0u ? mine : 1u; nx = cnt > 0u ? cnt : 1u;
}

__device__ __forceinline__ void xcd_barrier(const XcdBarrier& b) {
    asm volatile("s_waitcnt vmcnt(0)" ::: "memory");
    __syncthreads();
    if (threadIdx.x == 0) {
        unsigned* bar = b.bar;
        __builtin_amdgcn_s_waitcnt(0);
        unsigned nloc = b.st[0], nx = b.st[1];
        if (nloc == 0u) { xcd_barrier_complete(bar, b.x, nloc, nx); b.st[0] = nloc; b.st[1] = nx; }
        const unsigned old = xb_add(&bar[XB_XSUB(b.x)], 1u);
        const unsigned gen = old / nloc;
        if (old + 1u == (gen + 1u) * nloc) {
            __builtin_amdgcn_fence(__ATOMIC_RELEASE, "agent");
            asm volatile("s_waitcnt vmcnt(0)" ::: "memory");
            const unsigned og = xb_add(&bar[XB_TOP], 1u);
            const unsigned tg = og / nx;
            __builtin_amdgcn_fence(__ATOMIC_ACQUIRE, "agent");
            if (og + 1u == (tg + 1u) * nx) xb_add(&bar[XB_TOPGEN], 1u);
            else XB_SPIN(xb_ld(&bar[XB_TOPGEN]) == tg, bar);
            xb_add(&bar[XB_XGEN(b.x)], 1u);
            asm volatile("s_waitcnt vmcnt(0)" ::: "memory");
        } else {
            __builtin_amdgcn_fence(__ATOMIC_ACQUIRE, "agent");
            XB_SPIN(xb_ld(&bar[XB_XGEN(b.x)]) == gen, bar);
            asm volatile("s_waitcnt vmcnt(0)" ::: "memory");
        }
    }
    __syncthreads();
}
namespace cg = cooperative_groups;
constexpr int NWAVES = 8, NTHR = 512;
constexpr int D = 1024, BATCH = 8, SEQ = 4096, CTXL = 256, M_LAT = BATCH * SEQ, M_CTX = BATCH * CTXL, M_ALL = M_LAT + M_CTX;
constexpr int DFF = 4096, NIN0 = 5888;
constexpr int OFF_X = 0, OFF_B = 1024, OFF_DT = 1280, OFF_K = 1312, OFF_V = 2336, OFF_C = 3360, OFF_Z = 3616, OFF_Q = 4640, IN0 = 5664;
constexpr int NCH = 34;
constexpr float RMS_EPS = 1e-6f, LOG2E = 1.4426950408889634f;
constexpr size_t MiB = 1u << 20;
constexpr size_t WS_CTL = 0, CTL_ZERO_BYTES = 1024 * 1024;
constexpr size_t WS_SSQ = 64 * 1024, WS_BIASB = 576 * 1024;
constexpr size_t WS_TICKET = 32 * 1024;
constexpr size_t WS_PCNT = 960 * 1024;
constexpr size_t WS_WSV = 1 * MiB + 768 * 1024;
constexpr size_t WS_MOD = 1 * MiB, WS_MODCTX = 1 * MiB + 512 * 1024;
constexpr size_t WS_WIN = 2 * MiB, WS_WOUT = 14 * MiB;
constexpr size_t WS_H = 18 * MiB;
constexpr size_t WS_XBC = 86 * MiB;
constexpr size_t WS_ZQ = 188 * MiB;
constexpr size_t WS_KV = 316 * MiB;
constexpr size_t WS_DTRAW = 452 * MiB;
constexpr size_t WS_BC = 457 * MiB, WS_CC = 474 * MiB;
constexpr size_t WS_LA = 490 * MiB, WS_LD = 495 * MiB, WS_ATOT = 500 * MiB;
constexpr size_t WS_END = 504 * MiB;
constexpr size_t WS_XB = 124 * MiB;
constexpr size_t WS_YTMP = 124 * MiB;
constexpr size_t WS_W1T0 = 86 * MiB, WS_W2T0 = 94 * MiB, WS_W1T1 = 102 * MiB, WS_W2T1 = 110 * MiB, WS_SCIN = 118 * MiB, WS_SCOUT = 502 * MiB;
constexpr size_t WS_YF = 316 * MiB, WS_YB = 380 * MiB;
constexpr size_t WS_HID = 188 * MiB;
constexpr size_t WS_P1 = 188 * MiB, WS_G1 = 380 * MiB;
constexpr int RING_BYTES = 131072, LDSCTL_OFF = RING_BYTES, MISC_OFF = LDSCTL_OFF + 320, LDS_BYTES = 147456;

typedef short s16x4 __attribute__((ext_vector_type(4)));
typedef float f32x16 __attribute__((ext_vector_type(16)));
typedef float f32x2 __attribute__((ext_vector_type(2)));
typedef __bf16 bf16x2_t __attribute__((ext_vector_type(2)));
typedef LAS unsigned char* lptr;
__device__ __forceinline__ unsigned cvtpk(float lo, float hi) { f32x2 v = {lo, hi}; bf16x2_t b = __builtin_convertvector(v, bf16x2_t); return __builtin_bit_cast(unsigned, b); }
__device__ __forceinline__ float bflo(unsigned u) { return __uint_as_float(u << 16); }
__device__ __forceinline__ float bfhi(unsigned u) { return __uint_as_float(u & 0xffff0000u); }
__device__ __forceinline__ float silu_f(float v) { return v * __builtin_amdgcn_rcpf(1.f + __expf(-v)); }
__device__ __forceinline__ float softplus_f(float v) {
    const float x = __expf(-fabsf(v)); const float lp = x < 0.015625f ? x * (1.f + x * (-0.5f + x * (0.33333334f - 0.25f * x))) : __logf(1.f + x); return fmaxf(v, 0.f) + lp; }
__device__ __forceinline__ int crow(int r, int hi) { return (r & 3) + 8 * (r >> 2) + 4 * hi; }
__device__ __forceinline__ int clampi(int v, int lo, int hi) { return v < lo ? lo : (v > hi ? hi : v); }
__device__ __forceinline__ s16x4 trd(lptr p) { typedef short v4i16_t __attribute__((ext_vector_type(4))); return __builtin_bit_cast(s16x4, __builtin_amdgcn_ds_read_tr16_b64_v4i16((LAS v4i16_t*)p)); }
__device__ __forceinline__ bf16x8 cat8(s16x4 a, s16x4 b) { return (bf16x8){a[0], a[1], a[2], a[3], b[0], b[1], b[2], b[3]}; }
#define MFMA32(a, b, c) __builtin_amdgcn_mfma_f32_32x32x16_bf16((a), (b), (c), 0, 0, 0)
__device__ __forceinline__ unsigned off_b(unsigned row, unsigned ch) { return 256u * row + 16u * (ch ^ (((row & 3) << 2) | ((row >> 2) & 3))); }

#define WG_BAR() do { asm volatile("s_waitcnt lgkmcnt(0)" ::: "memory"); __builtin_amdgcn_s_barrier(); asm volatile("" ::: "memory"); } while (0)
__device__ __forceinline__ void glds16(const void* gsrc, unsigned lds_dst) { unsigned keep;
    asm volatile("s_mov_b32 %0, m0\n\ts_mov_b32 m0, %2\n\ts_nop 0\n\tglobal_load_lds_dwordx4 %1, off\n\ts_mov_b32 m0, %0" : "=&s"(keep) : "v"(gsrc), "s"(lds_dst) : "memory"); }
__device__ __forceinline__ void stwt16(void* p, v4u v) { asm volatile("global_store_dwordx4 %0, %1, off sc1\n\ts_nop 1" :: "v"(p), "v"(v) : "memory"); }
__device__ __forceinline__ void stwt8(void* p, unsigned long long v) { asm volatile("global_store_dwordx2 %0, %1, off sc1\n\ts_nop 0" :: "v"(p), "v"(v) : "memory"); }
struct Args {
    const float* in[23]; float* out; unsigned char* ws; int ph_lo, ph_hi, use_cg, pad;
};

__device__ __forceinline__ void transpose_block(const float* W, int ldw, int K, bf16* WT, int dst_row0, int src_col0, int kb, LAS float* scr, int lane) {
    const int k0 = 64 * kb;
    f32x4 v[8];
#pragma unroll
    for (int i = 0; i < 8; ++i) v[i] = __builtin_nontemporal_load((const GAS f32x4*)(W + (size_t)(k0 + (lane >> 3) + 8 * i) * ldw + src_col0 + 4 * (lane & 7)));
#pragma unroll
    for (int i = 0; i < 8; ++i) { LAS float* d = scr + ((lane >> 3) + 8 * i) * 33 + 4 * (lane & 7); d[0] = v[i].x; d[1] = v[i].y; d[2] = v[i].z; d[3] = v[i].w; }
    LDS_WAIT(); asm volatile("" ::: "memory");
    const int c = lane & 7;
#pragma unroll
    for (int j = 0; j < 4; ++j) { const int n = (lane >> 3) + 8 * j; const LAS float* s = scr + (8 * c) * 33 + n;
        v4u o; o.x = cvtpk(s[0 * 33], s[1 * 33]); o.y = cvtpk(s[2 * 33], s[3 * 33]); o.z = cvtpk(s[4 * 33], s[5 * 33]); o.w = cvtpk(s[6 * 33], s[7 * 33]);
        *(GAS v4u*)(WT + (size_t)(dst_row0 + n) * K + k0 + 8 * c) = o; }
    LDS_WAIT(); asm volatile("" ::: "memory");
}
__device__ __forceinline__ void transpose_plain(const float* W, int K, int N, bf16* WT, int item, LAS float* scr, int lane) {
    const int nblk = N / 32, kb = item / nblk, nb = item % nblk;
    transpose_block(W, N, K, WT, 32 * nb, 32 * nb, kb, scr, lane);
}
template <bool REMAP>
__device__ __forceinline__ void transpose_bias_t(const float* W, int K, int N, bf16* WT, int item, LAS float* scr, int lane, const float* shift, float* bias, int bstride) {
    const int nblk = N / 32, kb = item / nblk, nb = item % nblk, k0 = 64 * kb;
    int srcc = 32 * nb; if (REMAP && srcc >= 1024) { const int t = (srcc - 1024) >> 8, wv_ = (srcc - 1024) & 255; srcc = wv_ < 128 ? 1024 + 128 * t + wv_ : 2048 + 128 * t + wv_ - 128; }
    LAS float* sh = scr + 64 * 33 + 16;
#pragma unroll
    for (int i = 0; i < 8; ++i) sh[i * 64 + lane] = shift[(size_t)i * 6144 + k0 + lane];
    f32x4 v[8];
#pragma unroll
    for (int i = 0; i < 8; ++i) v[i] = __builtin_nontemporal_load((const GAS f32x4*)(W + (size_t)(k0 + (lane >> 3) + 8 * i) * N + srcc + 4 * (lane & 7)));
#pragma unroll
    for (int i = 0; i < 8; ++i) { LAS float* d = scr + ((lane >> 3) + 8 * i) * 33 + 4 * (lane & 7); d[0] = v[i].x; d[1] = v[i].y; d[2] = v[i].z; d[3] = v[i].w; }
    LDS_WAIT(); asm volatile("" ::: "memory");
    { const int n = lane & 31, b0 = 4 * (lane >> 5); float acc4[4] = {0.f, 0.f, 0.f, 0.f};
      for (int kk = 0; kk < 64; ++kk) { const float wv = scr[kk * 33 + n];
#pragma unroll
          for (int q = 0; q < 4; ++q) acc4[q] += sh[(b0 + q) * 64 + kk] * wv; }
#pragma unroll
      for (int q = 0; q < 4; ++q) atomicAdd(bias + (size_t)(b0 + q) * bstride + 32 * nb + n, acc4[q]); }
    const int c = lane & 7;
#pragma unroll
    for (int j = 0; j < 4; ++j) { const int n = (lane >> 3) + 8 * j; const LAS float* s = scr + (8 * c) * 33 + n;
        v4u o; o.x = cvtpk(s[0 * 33], s[1 * 33]); o.y = cvtpk(s[2 * 33], s[3 * 33]); o.z = cvtpk(s[4 * 33], s[5 * 33]); o.w = cvtpk(s[6 * 33], s[7 * 33]);
        *(GAS v4u*)(WT + (size_t)(32 * nb + n) * K + k0 + 8 * c) = o; }
    LDS_WAIT(); asm volatile("" ::: "memory");
}
__device__ __forceinline__ void transpose_plain_bias(const float* W, int K, int N, bf16* WT, int item, LAS float* scr, int lane, const float* shift, float* bias, int bstride) { transpose_bias_t<false>(W, K, N, WT, item, scr, lane, shift, bias, bstride); }
__device__ __forceinline__ void transpose_remap_bias(const float* W, int K, int N, bf16* WT, int item, LAS float* scr, int lane, const float* shift, float* bias, int bstride) { transpose_bias_t<true>(W, K, N, WT, item, scr, lane, shift, bias, bstride); }
__device__ __forceinline__ int in0_src_col(int dst) {
    if (dst < 1024) return OFF_X + dst;
    if (dst < 1280) return OFF_B + dst - 1024;
    if (dst < 1536) return OFF_C + dst - 1280;
    if (dst < 2560) return OFF_Z + dst - 1536;
    if (dst < 3584) return OFF_Q + dst - 2560;
    if (dst < 4608) return OFF_K + dst - 3584;
    if (dst < 5632) return OFF_V + dst - 4608;
    return OFF_DT + dst - 5632;
}
__device__ __forceinline__ void p0_prologue(const Args& A, lptr lds, int tid, int vcu, int G) {
    unsigned char* ws = A.ws;
    {
        const int task = blockIdx.x % 256, layer = task >> 7, n0 = (task & 127) * 48;
        LAS float* sc = (LAS float*)lds;
        LAS float* red = (LAS float*)(lds + 9 * 4096);
        const int c4 = tid & 15, kp = tid >> 4, wave = tid >> 6; const bool act = c4 < 12;
        const float* wp = A.in[4] + (size_t)layer * D * 6 * D + n0 + 4 * (act ? c4 : 0) + (size_t)(kp * 32) * 6 * D;
        f32x4 wv[32];
#pragma unroll
        for (int q = 0; q < 16; ++q) wv[q] = __builtin_nontemporal_load((const GAS f32x4*)(wp + (size_t)q * 6 * D));
#pragma unroll 6
        for (int i = tid; i < 9 * 1024; i += NTHR) { const float v = i < 8192 ? A.in[1][i] : A.in[3][i - 8192]; sc[i] = silu_f(v); }
#pragma unroll
        for (int q = 16; q < 32; ++q) wv[q] = __builtin_nontemporal_load((const GAS f32x4*)(wp + (size_t)q * 6 * D));
        __syncthreads();
        f32x4 acc[9];
#pragma unroll
        for (int bb = 0; bb < 9; ++bb) acc[bb] = (f32x4){0.f, 0.f, 0.f, 0.f};
#pragma unroll
        for (int q4 = 0; q4 < 8; ++q4) { asm volatile("" ::: "memory"); __builtin_amdgcn_sched_barrier(0);
#pragma unroll
            for (int bb = 0; bb < 9; ++bb) { const f32x4 s = *(const LAS f32x4*)(sc + bb * 1024 + kp * 32 + 4 * q4);
                acc[bb] += wv[4 * q4] * s.x; acc[bb] += wv[4 * q4 + 1] * s.y; acc[bb] += wv[4 * q4 + 2] * s.z; acc[bb] += wv[4 * q4 + 3] * s.w;
                asm volatile("" : "+v"(acc[bb])); } }
#pragma unroll
        for (int bb = 0; bb < 9; ++bb) {
#pragma unroll
            for (int e = 0; e < 4; ++e) { float v = acc[bb][e]; v += __shfl_xor(v, 16); v += __shfl_xor(v, 32); acc[bb][e] = v; }
            if ((tid & 63) < 12) *(LAS f32x4*)(red + (wave * 9 + bb) * 64 + 4 * c4) = acc[bb]; }
        __syncthreads();
        float* MOD = (float*)(ws + WS_MOD); float* MODCTX = (float*)(ws + WS_MODCTX);
        for (int i = tid; i < 9 * 64; i += NTHR) { const int bb = i >> 6, cc = i & 63; if (cc >= 48) continue; float s = A.in[5][layer * 6 * D + n0 + cc];
#pragma unroll
            for (int q = 0; q < 8; ++q) s += red[(q * 9 + bb) * 64 + cc];
            if (bb < 8) MOD[(size_t)(layer * 8 + bb) * 6 * D + n0 + cc] = s; else if (layer == 0 && n0 + cc < 2 * D) MODCTX[n0 + cc] = s; }
        __syncthreads();
    }
}
__device__ __forceinline__ void early_weights(const Args& A, lptr lds, int tid, int vcu, int G) {
    const int lane = tid & 63, wave = tid >> 6;
    unsigned char* ws = A.ws;
    LAS float* scr = (LAS float*)(lds + wave * 16384);
    const int gw = vcu * NWAVES + wave, NGW = G * NWAVES;
    bf16* WIN = (bf16*)(ws + WS_WIN); bf16* WOUT = (bf16*)(ws + WS_WOUT);
    constexpr int I_IN = (IN0 / 32) * (D / 64), I_OUT = (D / 32) * (2 * D / 64);
    for (int it = gw; it < I_IN + I_OUT; it += NGW) {
        if (it < I_IN) { const int nb = it % (IN0 / 32), kb = it / (IN0 / 32); transpose_block(A.in[10], IN0, D, WIN, 32 * nb, in0_src_col(32 * nb), kb, scr, lane); }
        else transpose_plain(A.in[18], 2 * D, D, WOUT, it - I_IN, scr, lane);
    }
    { const int gt = vcu * NTHR + tid, NGT = G * NTHR; v4u z = {0u, 0u, 0u, 0u};
      for (int i = gt; i < 224 * 128; i += NGT) *(GAS v4u*)((unsigned char*)WIN + (size_t)IN0 * 2048 + (size_t)i * 16) = z; }
}
__device__ __forceinline__ void late_item(const Args& A, int r, LAS float* scr, int lane) {
    unsigned char* ws = A.ws;
    constexpr int I_1 = (DFF / 32) * (D / 64), I_2 = (D / 32) * (DFF / 64), I_SI = (3 * D / 32) * (D / 64);
    const float* MODp = (const float*)(ws + WS_MOD); float* BIASB = (float*)(ws + WS_BIASB);
    if (r < I_1) { transpose_plain_bias(A.in[8], D, DFF, (bf16*)(ws + WS_W1T0), r, scr, lane, MODp + 3 * D, BIASB, 4096); return; } r -= I_1;
    if (r < I_1) { transpose_plain_bias(A.in[8] + (size_t)D * DFF, D, DFF, (bf16*)(ws + WS_W1T1), r, scr, lane, MODp + (size_t)8 * 6 * D + 3 * D, BIASB + 2 * 8 * 4096, 4096); return; } r -= I_1;
    if (r < I_2) { transpose_plain(A.in[9], DFF, D, (bf16*)(ws + WS_W2T0), r, scr, lane); return; } r -= I_2;
    if (r < I_2) { transpose_plain(A.in[9] + (size_t)DFF * D, DFF, D, (bf16*)(ws + WS_W2T1), r, scr, lane); return; } r -= I_2;
    if (r < I_SI) { transpose_remap_bias(A.in[19], D, 3 * D, (bf16*)(ws + WS_SCIN), r, scr, lane, MODp + (size_t)8 * 6 * D, BIASB + 1 * 8 * 4096, 4096); return; } r -= I_SI;
    transpose_plain(A.in[21], D, D, (bf16*)(ws + WS_SCOUT), r, scr, lane);
}
__device__ __forceinline__ void late_weights(const Args& A, lptr lds, int tid, int vcu, int G) {
    const int lane = tid & 63, wave = tid >> 6; unsigned char* ws = A.ws;
    LAS float* scr = (LAS float*)(lds + wave * 16384);
    constexpr int I_1 = (DFF / 32) * (D / 64), I_2 = (D / 32) * (DFF / 64), I_SI = (3 * D / 32) * (D / 64), I_SO = (D / 32) * (D / 64);
    constexpr int TOT = 2 * I_1 + 2 * I_2 + I_SI + I_SO;
    (void)vcu; (void)G;
    const int pq = blockIdx.x & 7; unsigned* tk = (unsigned*)(ws + WS_TICKET) + 64 * (8 + pq);
    unsigned tv = 0u; if (lane == 0) tv = __hip_atomic_fetch_add(tk, 1u, __ATOMIC_RELAXED, __HIP_MEMORY_SCOPE_AGENT);
#define LW_ITEM(t_) ((int)(((t_) >> 3) * 64u + 8u * (unsigned)pq + ((t_) & 7u)))
    int it = LW_ITEM(__builtin_amdgcn_readfirstlane(tv));
    while (it < TOT) {
        unsigned tn = 0u; if (lane == 0) tn = __hip_atomic_fetch_add(tk, 1u, __ATOMIC_RELAXED, __HIP_MEMORY_SCOPE_AGENT);
        late_item(A, it, scr, lane);
        it = LW_ITEM(__builtin_amdgcn_readfirstlane(tn));
    }
#undef LW_ITEM
}
__device__ __forceinline__ void norm_row_bf16(const float* xrow, const float* w, const float* shift, const float* scale, bf16* orow, int lane) {
    const GAS f32x4* xr = (const GAS f32x4*)xrow + 2 * lane;
    f32x4 v[4]; float s = 0.f;
#pragma unroll
    for (int j = 0; j < 2; ++j) { v[2 * j] = __builtin_nontemporal_load(xr + 128 * j); v[2 * j + 1] = __builtin_nontemporal_load(xr + 128 * j + 1);
        s += (v[2 * j].x * v[2 * j].x + v[2 * j].y * v[2 * j].y) + (v[2 * j].z * v[2 * j].z + v[2 * j].w * v[2 * j].w);
        s += (v[2 * j + 1].x * v[2 * j + 1].x + v[2 * j + 1].y * v[2 * j + 1].y) + (v[2 * j + 1].z * v[2 * j + 1].z + v[2 * j + 1].w * v[2 * j + 1].w); }
    const float rstd = rsqrtf(wave_sum(s) * (1.f / D) + RMS_EPS);
#pragma unroll
    for (int j = 0; j < 2; ++j) { const int c = 8 * lane + 512 * j; v4u o;
#pragma unroll
        for (int q = 0; q < 2; ++q) { const f32x4 wv = *(const f32x4*)(w + c + 4 * q), sh = *(const f32x4*)(shift + c + 4 * q), sc = *(const f32x4*)(scale + c + 4 * q);
            const f32x4 h = v[2 * j + q] * rstd * wv * (sc + 1.f) + sh;
            o[2 * q] = cvtpk(h.x, h.y); o[2 * q + 1] = cvtpk(h.z, h.w); }
        *(GAS v4u*)(orow + c) = o; }
}
__device__ __forceinline__ void norm_phase(const Args& A, const float* src, const float* w, int layer, int sel  , bool with_ctx, int tid, int vcu, int G) {
    const int lane = tid & 63, wave = tid >> 6, gw = vcu * NWAVES + wave, NGW = G * NWAVES;
    const float* MOD = (const float*)(A.ws + WS_MOD); const float* MODCTX = (const float*)(A.ws + WS_MODCTX);
    bf16* H = (bf16*)(A.ws + WS_H);
    const int nrows = with_ctx ? M_ALL : M_LAT;
    for (int r = gw; r < nrows; r += NGW) {
        if (r < M_LAT) { const float* mb = MOD + (size_t)(layer * 8 + (r >> 12)) * 6 * D + (sel ? 3 * D : 0);
            norm_row_bf16(src + (size_t)r * D, w, mb, mb + D, H + (size_t)r * D, lane); }
        else norm_row_bf16(A.in[2] + (size_t)(r - M_LAT) * D, w, MODCTX, MODCTX + D, H + (size_t)r * D, lane);
    }
}
__device__ __forceinline__ void wsv_phase(const Args& A, int tid) {
    const float* MOD = (const float*)(A.ws + WS_MOD); float* WSV = (float*)(A.ws + WS_WSV);
    for (int i = tid; i < 3 * 8 * 1024; i += NTHR) { const int site = i >> 13, b = (i >> 10) & 7, c = i & 1023;
        const float nw = site == 0 ? A.in[7][c] : (site == 1 ? A.in[6][D + c] : A.in[7][D + c]);
        const float sc = site == 0 ? MOD[(size_t)b * 6 * D + 4 * D + c] : (site == 1 ? MOD[(size_t)(8 + b) * 6 * D + 1 * D + c] : MOD[(size_t)(8 + b) * 6 * D + 4 * D + c]);
        WSV[i] = nw * (1.f + sc); }
}
__device__ __forceinline__ void final_norm_phase(const Args& A, int tid, int vcu, int G) {
    const int lane = tid & 63, wave = tid >> 6, gw = vcu * NWAVES + wave, NGW = G * NWAVES;
    const float* w = A.in[22];
    for (int r = gw; r < M_LAT; r += NGW) {
        GAS f32x4* xr = (GAS f32x4*)(A.out + (size_t)r * D) + lane;
        f32x4 v[4]; float s = 0.f;
#pragma unroll
        for (int j = 0; j < 4; ++j) { v[j] = xr[64 * j]; s += (v[j].x * v[j].x + v[j].y * v[j].y) + (v[j].z * v[j].z + v[j].w * v[j].w); }
        const float rstd = rsqrtf(wave_sum(s) * (1.f / D) + RMS_EPS);
#pragma unroll
        for (int j = 0; j < 4; ++j) xr[64 * j] = v[j] * rstd * *(const f32x4*)(w + 4 * lane + 256 * j);
    }
}
constexpr int NA_K0 = 0, NA_V0 = 32768, NA_TBL = 65536, NA_WSF = 65536 + 2560;
__device__ __forceinline__ unsigned kv_off(unsigned row, unsigned ch, unsigned sw) { return row * 128 + ((ch ^ sw) << 4); }
#define NA_TILE(baseA, baseB, WINDOW) do { \
    f32x16 p0, p1; \
    { const float ng = -m_run; _Pragma("unroll") for (int r = 0; r < 16; ++r) { p0[r] = ng; p1[r] = ng; } }     \
    if (PMODE != 5) { const unsigned rowA = (baseA) + r32, rowB = (baseB) + r32, swA = (rowA >> 1) & 7, swB = (rowB >> 1) & 7; \
      _Pragma("unroll") for (int s = 0; s < 4; ++s) { \
        const bf16x8 a0 = *(const LAS bf16x8*)(kb + kv_off(rowA, 2 * s + hi, swA)); \
        const bf16x8 a1 = *(const LAS bf16x8*)(kb + kv_off(rowB, 2 * s + hi, swB)); \
        p0 = MFMA32(a0, qf[s], p0); p1 = MFMA32(a1, qf[s], p1); } } \
    if (WINDOW && PMODE < 3) { \
        int clo = clo_; asm volatile("" : "+v"(clo)); \
        _Pragma("unroll") for (int r = 0; r < 16; ++r) { const int kcc = (r & 3) + 8 * (r >> 2); const bool cv = (unsigned)(kcc - clo) < 16u; \
            const float ba = tbA[kcc], bb = tbB[kcc]; const float sa = p0[r] + ba, sb = p1[r] + bb; \
            p0[r] = (cv && vA) ? sa : -1e30f; \
            p1[r] = (cv && vB) ? sb : -1e30f; } \
    } \
    if (PMODE < 3) { \
    float mt = __builtin_fmaxf(p0[0], p1[0]); \
    _Pragma("unroll") for (int r = 1; r < 16; ++r) mt = __builtin_fmaxf(__builtin_fmaxf(mt, p0[r]), p1[r]); \
    mt = fmaxf(mt, __shfl_xor(mt, 32)); \
    if (first_tile || __any(mt > 0.f)) { \
        const float dl = first_tile ? mt : fmaxf(mt, 0.f), alpha = __builtin_amdgcn_exp2f(-dl); \
        m_run += dl; l_run *= alpha; \
        _Pragma("unroll") for (int r = 0; r < 16; ++r) { p0[r] -= dl; p1[r] -= dl; } \
        if (hi == 0) wsf[r32] = alpha; \
        _Pragma("unroll") for (int g4 = 0; g4 < 4; ++g4) { const f32x4 aq = *(const LAS f32x4*)(wsf + 8 * g4 + 4 * hi); \
            _Pragma("unroll") for (int e = 0; e < 4; ++e) { o0[4 * g4 + e] *= aq[e]; o1[4 * g4 + e] *= aq[e]; } } \
        first_tile = false; \
    } \
    } \
      \
    if (PMODE >= 4) { _Pragma("unroll") for (int r = 0; r < 16; ++r) { o0[r] += p0[r]; o1[r] += p1[r]; } } else { \
    float rsum = 0.f; \
    _Pragma("unroll") for (int k = 0; k < 4; ++k) { v4u u; \
        _Pragma("unroll") for (int jj = 0; jj < 4; ++jj) { const int rr = 8 * (k & 1) + 2 * jj; \
            float e0 = (k < 2) ? p0[rr] : p1[rr], e1 = (k < 2) ? p0[rr + 1] : p1[rr + 1]; \
            if (PMODE < 3) { e0 = __builtin_amdgcn_exp2f(e0); e1 = __builtin_amdgcn_exp2f(e1); rsum += e0 + e1; } \
            u[jj] = cvtpk(e0, e1); } \
        const bf16x8 pak = __builtin_bit_cast(bf16x8, u); \
        const unsigned vrow = ((k < 2) ? (baseA) : (baseB)) + 16 * (k & 1); \
        { const s16x4 lo4 = trd(vb + voff0 + vrow * 128), hi4 = trd(vb + voff0 + (vrow + 8) * 128); o0 = MFMA32(pak, cat8(lo4, hi4), o0); } \
        { const s16x4 lo4 = trd(vb + voff1 + vrow * 128), hi4 = trd(vb + voff1 + (vrow + 8) * 128); o1 = MFMA32(pak, cat8(lo4, hi4), o1); } \
        __builtin_amdgcn_sched_barrier(0); } \
    l_run += rsum; } \
} while (0)
constexpr int NG_CK = 0, NG_CV = 32768, NG_RK = 65536, NG_RV = 98304, NG_TBL = 131072 + 1024, NG_WSF = NG_TBL + 2560;
template <int PMODE>
__device__ __forceinline__ void na_group(const Args& A, lptr lds, int b, int h, int band0, int tid, bf16* OUT) {
    const int lane = tid & 63, w = __builtin_amdgcn_readfirstlane(tid >> 6), r32 = lane & 31, hi = lane >> 5;
    const bf16* KV = (const bf16*)(A.ws + WS_KV); const bf16* ZQ = (const bf16*)(A.ws + WS_ZQ);
    const int rp = w >> 2, jb = w & 3, qcol = 16 * jb + (r32 & 15), kc0 = clampi(16 * jb - 8, 0, 32);
    LAS float* tbl = (LAS float*)(lds + NG_TBL);
    LAS float* wsf = (LAS float*)(lds + NG_WSF) + w * 64;
    const int skey = tid >> 3, sch = tid & 7;
    const unsigned kw0 = kv_off(skey, sch, (skey >> 1) & 7), kw1 = kv_off(skey + 64, sch, ((skey + 64) >> 1) & 7);
    const unsigned vw0 = kv_off(skey, sch, ((skey >> 1) & 1) << 2), vw1 = kv_off(skey + 64, sch, (((skey + 64) >> 1) & 1) << 2);
    const int clo_ = clampi(qcol - 8, 0, 48) - kc0 - 4 * hi;
    const int q4 = (lane & 15) >> 2, p4 = lane & 3, blk = (lane >> 4) & 1;
    const unsigned vsw = ((q4 >> 1) & 1) << 2, vx = 2 * blk + (p4 >> 1);
    const unsigned voff0 = (4 * hi + q4) * 128 + ((vx ^ vsw) << 4) + 8 * (p4 & 1), voff1 = (4 * hi + q4) * 128 + (((4 + vx) ^ vsw) << 4) + 8 * (p4 & 1);
    for (int i = tid; i < 640; i += NTHR) tbl[i] = (i >= 64 && i < 64 + 465) ? A.in[17][h * 465 + i - 64] * LOG2E : 0.f;
#pragma unroll
    for (int i = 0; i < 4; ++i) { const int key = skey + 64 * i; const bf16* p_ = KV + ((size_t)M_LAT + b * CTXL + key) * 2048 + h * 64 + sch * 8;
        const v4u kk = *(const GAS v4u*)p_, vv = *(const GAS v4u*)(p_ + 1024);
        *(LAS v4u*)(lds + NG_CK + kv_off(key, sch, (key >> 1) & 7)) = kk; *(LAS v4u*)(lds + NG_CV + kv_off(key, sch, ((key >> 1) & 1) << 2)) = vv; }
    v4u kreg0, kreg1, vreg0, vreg1;
#define NG_RLO(band) clampi(4 * (band) - 4, 0, 56)
#define NG_RHI(band) (clampi(4 * (band) - 1, 0, 56) + 7)
#define NG_LOAD(band, st) do { const int ka_ = NG_RLO(band) + 2 * (st), kb_ = ka_ + 1 > NG_RHI(band) ? NG_RHI(band) : ka_ + 1; \
        const bf16* p0_ = KV + ((size_t)b * SEQ + ka_ * 64 + skey) * 2048 + h * 64 + sch * 8; const bf16* p1_ = KV + ((size_t)b * SEQ + kb_ * 64 + skey) * 2048 + h * 64 + sch * 8; \
        kreg0 = *(const GAS v4u*)p0_; vreg0 = *(const GAS v4u*)(p0_ + 1024); kreg1 = *(const GAS v4u*)p1_; vreg1 = *(const GAS v4u*)(p1_ + 1024); } while (0)
#define NG_STORE(buf) do { lptr kd_ = lds + NG_RK + (buf) * 16384, vd_ = lds + NG_RV + (buf) * 16384; \
        *(LAS v4u*)(kd_ + kw0) = kreg0; *(LAS v4u*)(kd_ + kw1) = kreg1; *(LAS v4u*)(vd_ + vw0) = vreg0; *(LAS v4u*)(vd_ + vw1) = vreg1; } while (0)
#define NG_QLOAD(dst, band) do { const int qrow_ = 4 * (band) + 2 * rp + (r32 >> 4); const bf16* qp_ = ZQ + ((size_t)b * SEQ + qrow_ * 64 + qcol) * 2048 + 1024 + h * 64; \
        _Pragma("unroll") for (int s_ = 0; s_ < 4; ++s_) dst[s_] = *(const bf16x8*)(qp_ + 16 * s_ + 8 * hi); } while (0)
    bf16x8 qf[4], qn[4];
    NG_QLOAD(qf, band0);
    NG_LOAD(band0, 0); NG_STORE(0);
    __syncthreads();
    int cnt = 0;
    for (int ub = 0; ub < 8; ++ub) {
        const int band = band0 + ub;
        const int qr0 = 4 * band + 2 * rp, qrow = qr0 + (r32 >> 4);
        const int rlo = NG_RLO(band), rhi = NG_RHI(band), nrows = rhi - rlo + 1, nsteps = (nrows + 1) >> 1;
        const int rsq = clampi(qrow - 4, 0, 56), rsw0 = clampi(qr0 - 4, 0, 56), rsw1 = clampi(qr0 + 1 - 4, 0, 56) + 7;
        float m_run = 0.f, l_run = 0.f; bool first_tile = true;
        f32x16 o0, o1;
#pragma unroll
        for (int r = 0; r < 16; ++r) { o0[r] = 0.f; o1[r] = 0.f; }
        if (PMODE != 2) {
            lptr kb = lds + NG_CK, vb = lds + NG_CV;
            const bool vA = true, vB = true; const LAS float* tbA = tbl; const LAS float* tbB = tbl; (void)vA; (void)vB; (void)tbA; (void)tbB;
            NA_TILE(0, 32, false); NA_TILE(64, 96, false); NA_TILE(128, 160, false); NA_TILE(192, 224, false);
        }
        for (int st = 0; st < nsteps; ++st) {
            const int buf = cnt & 1;
            if (st + 1 < nsteps) NG_LOAD(band, st + 1);
            else if (ub < 7) { NG_LOAD(band + 1, 0); NG_QLOAD(qn, band + 1); }
            lptr kb = lds + NG_RK + buf * 16384, vb = lds + NG_RV + buf * 16384;
            const int ka = rlo + 2 * st, kbr = ka + 1;
            const bool useA = (ka >= rsw0 && ka <= rsw1), useB = (kbr <= rhi && kbr >= rsw0 && kbr <= rsw1);
            if ((useA || useB) && PMODE != 1) {
                const bool vA = useA && (ka >= rsq && ka < rsq + 8), vB = useB && (kbr >= rsq && kbr < rsq + 8);
                const LAS float* tbA = tbl + 64 + clampi(ka - qrow + 7, 0, 14) * 31 + 15 + kc0 + 4 * hi - qcol;
                const LAS float* tbB = tbl + 64 + clampi(kbr - qrow + 7, 0, 14) * 31 + 15 + kc0 + 4 * hi - qcol;
                NA_TILE(kc0, 64 + kc0, true);
            }
            if (st + 1 < nsteps || ub < 7) NG_STORE(buf ^ 1);
            WG_BAR();
            ++cnt;
        }
        const float lt = l_run + __shfl_xor(l_run, 32);
        if (hi == 0) wsf[r32] = 1.f / lt;
        { const int sb = (cnt & 1) ^ 1;
          LAS unsigned short* stg = (LAS unsigned short*)(lds + (w < 4 ? NG_RK + sb * 16384 + w * 4096 : NG_RV + sb * 16384 + (w - 4) * 4096));
#pragma unroll
          for (int g4 = 0; g4 < 4; ++g4) { const f32x4 iq = *(const LAS f32x4*)(wsf + 8 * g4 + 4 * hi);
#pragma unroll
            for (int e = 0; e < 4; ++e) { const int r = 4 * g4 + e, q = crow(r, hi); const float inv = iq[e];
                stg[q * 64 + r32] = (unsigned short)(cvtpk(o0[r] * inv, 0.f) & 0xffffu);
                stg[q * 64 + 32 + r32] = (unsigned short)(cvtpk(o1[r] * inv, 0.f) & 0xffffu); } }
#pragma unroll
          for (int i = 0; i < 4; ++i) { const int q = i * 8 + (lane >> 3), ch = lane & 7;
            const v4u v = *(const LAS v4u*)(stg + q * 64 + ch * 8);
            const size_t tok = (size_t)b * SEQ + (qr0 + (q >> 4)) * 64 + 16 * jb + (q & 15);
            *(GAS v4u*)(OUT + tok * 2048 + 1024 + h * 64 + ch * 8) = v; } }
        WG_BAR();
#pragma unroll
        for (int s = 0; s < 4; ++s) qf[s] = qn[s];
    }
    __syncthreads();
#undef NG_RLO
#undef NG_RHI
#undef NG_LOAD
#undef NG_STORE
#undef NG_QLOAD
}

constexpr int PREP_WLDS = 16384, PREP_XITEMS = BATCH * NCH * 24, PREP_ITEMS = PREP_XITEMS + BATCH * NCH;
__device__ __forceinline__ unsigned slab_off(unsigned row, unsigned ch) { return row * 128 + ((ch ^ (((row >> 1) & 1) << 2)) << 4); }
__device__ __forceinline__ void prep_item(const Args& A, lptr wl, int item, int lane) {
    if (item < PREP_XITEMS) {
        const int ca = item / 24, cg = item % 24, b = ca / NCH, cid_all = ca % NCH; const bool is_ctx = cid_all < 2;
        if (is_ctx && cg >= 20) return;
        const int cid = is_ctx ? cid_all : cid_all - 2, L = is_ctx ? CTXL : SEQ, t0 = 128 * cid; const size_t rowbase = is_ctx ? (size_t)M_LAT + b * CTXL : (size_t)b * SEQ;
        const bf16* XBC = (const bf16*)(A.ws + WS_XBC);
        const int v = lane & 7, tb = 16 * (lane >> 3), c0 = cg * 64 + v * 8;
        float wgt[3][8], bias[8];
#pragma unroll
        for (int k = 0; k < 3; ++k) { const f32x4 a = *(const f32x4*)(A.in[11] + k * 1536 + c0), c = *(const f32x4*)(A.in[11] + k * 1536 + c0 + 4);
#pragma unroll
            for (int e = 0; e < 4; ++e) { wgt[k][e] = a[e]; wgt[k][4 + e] = c[e]; } }
        { const f32x4 a = *(const f32x4*)(A.in[12] + c0), c = *(const f32x4*)(A.in[12] + c0 + 4);
#pragma unroll
          for (int e = 0; e < 4; ++e) { bias[e] = a[e]; bias[4 + e] = c[e]; } }
        const bf16* src = XBC + (rowbase + t0 + tb) * 1536 + c0;
        const v4u zero4 = {0u, 0u, 0u, 0u};
        v4u up = (t0 + tb - 1 >= 0) ? *(const GAS v4u*)(src - 1536) : zero4, uc = *(const GAS v4u*)src;
        bf16* BC = (bf16*)(A.ws + WS_BC); bf16* CC = (bf16*)(A.ws + WS_CC);
#pragma unroll
        for (int i = 0; i < 16; ++i) {
            const v4u un = (t0 + tb + i + 1 < L) ? *(const GAS v4u*)(src + (size_t)(i + 1) * 1536) : zero4;
            v4u o;
#pragma unroll
            for (int e = 0; e < 4; ++e) {
                const float a0 = bias[2 * e] + wgt[0][2 * e] * bflo(up[e]) + wgt[1][2 * e] * bflo(uc[e]) + wgt[2][2 * e] * bflo(un[e]);
                const float a1 = bias[2 * e + 1] + wgt[0][2 * e + 1] * bfhi(up[e]) + wgt[1][2 * e + 1] * bfhi(uc[e]) + wgt[2][2 * e + 1] * bfhi(un[e]);
                o[e] = cvtpk(silu_f(a0), silu_f(a1)); }
            if (cg < 16) *(LAS v4u*)(wl + slab_off(tb + i, v)) = o;
            else if (cg < 20) *(GAS v4u*)(BC + (rowbase + t0 + tb + i) * 256 + (cg - 16) * 64 + v * 8) = o;
            else *(GAS v4u*)(CC + (rowbase + t0 + tb + i) * 256 + (cg - 20) * 64 + v * 8) = o;
            up = uc; uc = un;
        }
        if (cg < 16) {
            const int r32 = lane & 31, hi = lane >> 5, q4 = (lane & 15) >> 2, p4 = lane & 3, blk = (lane >> 4) & 1;
            bf16* XT = (bf16*)(A.ws + WS_H) + ((size_t)ca * 16 + cg) * 64 * 128;
#pragma unroll
            for (int c = 0; c < 2; ++c)
#pragma unroll
                for (int s = 0; s < 8; ++s) {
                    const unsigned ch = 4 * c + 2 * blk + (p4 >> 1), ra = 16 * s + 4 * hi + q4;
                    const s16x4 lo4 = trd(wl + slab_off(ra, ch) + 8 * (p4 & 1)), hi4 = trd(wl + slab_off(ra + 8, ch) + 8 * (p4 & 1));
                    *(GAS bf16x8*)(XT + (size_t)((c * 8 + s) * 64 + lane) * 8) = cat8(lo4, hi4);
                }
        }
        return;
    }
    {
        const int ca = item - PREP_XITEMS, b = ca / NCH, cid_all = ca % NCH; const bool is_ctx = cid_all < 2;
        const int cid = is_ctx ? cid_all : cid_all - 2, t0 = 128 * cid; const size_t rowbase = is_ctx ? (size_t)M_LAT + b * CTXL : (size_t)b * SEQ;
        const float* DTRAW = (const float*)(A.ws + WS_DTRAW) + (rowbase + t0) * 32;
        LAS float* las = (LAS float*)wl;
        float* LA = (float*)(A.ws + WS_LA); float* LD = (float*)(A.ws + WS_LD);
        const size_t obase = (size_t)(b * 2) * 16 * (NCH * 128) + cid_all * 128;
        const int jq = lane & 7;
        const f32x4 bj4 = *(const f32x4*)(A.in[13] + 4 * jq);
        f32x4 dtv[16];
#pragma unroll
        for (int i2 = 0; i2 < 16; ++i2) { const int t = (lane >> 3) + 8 * i2; const f32x4 raw = *(const GAS f32x4*)(DTRAW + t * 32 + 4 * jq);
#pragma unroll
            for (int e = 0; e < 4; ++e) dtv[i2][e] = softplus_f(raw[e] + bj4[e]); }
#pragma unroll
        for (int i2 = 0; i2 < 16; ++i2) { const int t = (lane >> 3) + 8 * i2;
#pragma unroll
            for (int e = 0; e < 4; ++e) { const int jj = 4 * jq + e; las[jj * 128 + ((t + jj) & 127)] = dtv[i2][e]; } }
        if (lane < 32) { const int jl = lane; const float Aj = -__expf(A.in[14][jl]) * LOG2E; float acc = 0.f;
            if (jl < 16) { for (int t = 0; t < 128; ++t) { const int o = jl * 128 + ((t + jl) & 127); acc += las[o] * Aj; las[o] = acc; } }
            else { for (int t = 127; t >= 0; --t) { const int o = jl * 128 + ((t + jl) & 127); acc += las[o] * Aj; las[o] = acc; } }
            ((float*)(A.ws + WS_ATOT))[((size_t)(b * 2) * 16 + jl) * NCH + cid_all] = acc; }
        for (int i = lane; i < 4096; i += 64) { const int jj = i >> 7, t = i & 127; LA[obase + (size_t)jj * (NCH * 128) + t] = las[jj * 128 + ((t + jj) & 127)]; }
#pragma unroll
        for (int i2 = 0; i2 < 16; ++i2) { const int t = (lane >> 3) + 8 * i2;
#pragma unroll
            for (int e = 0; e < 4; ++e) { const int jj = 4 * jq + e; las[jj * 128 + ((t + jj) & 127)] = __log2f(dtv[i2][e]); } }
        for (int i = lane; i < 4096; i += 64) { const int jj = i >> 7, t = i & 127; LD[obase + (size_t)jj * (NCH * 128) + t] = las[jj * 128 + ((t + jj) & 127)]; }
    }
}
constexpr int SD_BS = 0, SD_HS = 32768, SD_W = 49152;
constexpr size_t WS_HST = WS_KV;
template <int PMODE>
__device__ __forceinline__ void ssd_state_unit(const Args& A, lptr lds, int b, int h, int dir, int tid) {
    const int lane = tid & 63, w = __builtin_amdgcn_readfirstlane(tid >> 6), r32 = lane & 31, hi = lane >> 5, it = w >> 1, pt = w & 1, g = h >> 3;
    const bf16* BC = (const bf16*)(A.ws + WS_BC); const bf16* XT = (const bf16*)(A.ws + WS_H);
    const float* LA = (const float*)(A.ws + WS_LA) + ((size_t)(b * 2 + dir) * 16 + h) * (NCH * 128);
    const float* LD = (const float*)(A.ws + WS_LD) + ((size_t)(b * 2 + dir) * 16 + h) * (NCH * 128);
    const float* ATOT = (const float*)(A.ws + WS_ATOT) + ((size_t)(b * 2 + dir) * 16 + h) * NCH;
    bf16* HST = (bf16*)(A.ws + WS_HST);
    f32x16 st;
#pragma unroll
    for (int r = 0; r < 16; ++r) st[r] = 0.f;
    bf16x8 xnA[8], xnB[8]; v4u pbA[4], pbB[4]; float laA[4], ldA[4], laB[4], ldB[4], atA = 0.f, atB = 0.f;
    const int q4 = (lane & 15) >> 2, p4 = lane & 3, blk = (lane >> 4) & 1;
#define SD_CID(k) (dir == 0 ? (k) : ((k) < 2 ? 1 - (k) : 35 - (k)))
#define SD_PREFETCH_B(k, PB, LAN, LDN, ATN) do { const int ca_ = SD_CID(k); const bool cx_ = ca_ < 2; \
        const size_t rb_ = cx_ ? (size_t)M_LAT + b * CTXL + 128 * ca_ : (size_t)b * SEQ + 128 * (ca_ - 2); \
        _Pragma("unroll") for (int i_ = 0; i_ < 4; ++i_) { const int idx_ = tid + NTHR * i_, row_ = idx_ >> 4, ch_ = idx_ & 15; \
            PB[i_] = *(const GAS v4u*)(BC + (rb_ + row_) * 256 + g * 128 + ch_ * 8); } \
        _Pragma("unroll") for (int i_ = 0; i_ < 4; ++i_) { const int row_ = (tid >> 4) + 32 * i_; LAN[i_] = LA[ca_ * 128 + row_]; LDN[i_] = LD[ca_ * 128 + row_]; } ATN = ATOT[ca_]; } while (0)
#define SD_PREFETCH_X(k, XN) do { const int ca_ = SD_CID(k); \
        const bf16* xp_ = XT + (((size_t)b * NCH + ca_) * 16 + h) * (64 * 128) + (size_t)(pt * 8 * 64 + lane) * 8; \
        _Pragma("unroll") for (int s_ = 0; s_ < 8; ++s_) XN[s_] = *(const GAS bf16x8*)(xp_ + s_ * 512); } while (0)
#define SD_STEP(k, PB, XN, LAN, LDN, ATN) do { \
        const int ca = SD_CID(k); const bool is_ctx = ca < 2; lptr ldb = lds + ((k) & 1) * 49152; \
        const float atot = ATN; \
        _Pragma("unroll") for (int i = 0; i < 4; ++i) { const int idx = tid + NTHR * i, row = idx >> 4, ch = idx & 15; \
            const float wv_ = __builtin_amdgcn_exp2f(atot - LAN[i] + LDN[i]);        \
            v4u q_ = PB[i]; q_.x = cvtpk(bflo(q_.x) * wv_, bfhi(q_.x) * wv_); q_.y = cvtpk(bflo(q_.y) * wv_, bfhi(q_.y) * wv_); q_.z = cvtpk(bflo(q_.z) * wv_, bfhi(q_.z) * wv_); q_.w = cvtpk(bflo(q_.w) * wv_, bfhi(q_.w) * wv_); \
            *(LAS v4u*)(ldb + SD_BS + off_b(row, ch)) = q_; } \
        if (!is_ctx) { \
            _Pragma("unroll") for (int g4 = 0; g4 < 4; ++g4) { const unsigned lo = cvtpk(st[4 * g4], st[4 * g4 + 1]), hi2 = cvtpk(st[4 * g4 + 2], st[4 * g4 + 3]); \
                const unsigned long long v = (unsigned long long)lo | ((unsigned long long)hi2 << 32); \
                *(LAS unsigned long long*)(ldb + SD_HS + off_b(32 * pt + r32, 4 * it + g4) + 8 * hi) = v; } \
        } \
        WG_BAR(); \
        if ((k) + 2 < NCH) SD_PREFETCH_B((k) + 2, PB, LAN, LDN, ATN); \
        if (!is_ctx && PMODE != 2) { \
            bf16* dst = HST + ((((size_t)b * 32 + (ca - 2)) * 16 + h) * 2 + dir) * (64 * 128); \
            _Pragma("unroll") for (int i = 0; i < 2; ++i) { const int idx = tid + NTHR * i, f_ = idx >> 6, ln_ = idx & 63, row = 32 * (f_ >> 3) + (ln_ & 31), ch = 2 * (f_ & 7) + (ln_ >> 5);     \
                *(GAS v4u*)(dst + (size_t)idx * 8) = *(const LAS v4u*)(ldb + SD_HS + off_b(row, ch)); } \
        } \
        { int hiv = hi, q4v = q4, p4v = p4; asm volatile("" : "+v"(hiv), "+v"(q4v), "+v"(p4v)); \
          const float dec = __builtin_amdgcn_exp2f(atot); \
          _Pragma("unroll") for (int r = 0; r < 16; ++r) st[r] *= dec; \
          if (PMODE != 1) _Pragma("unroll") for (int s = 0; s < 8; ++s) { \
              const unsigned ch = 4 * it + 2 * blk + (p4v >> 1); \
              const s16x4 lo4 = trd(ldb + SD_BS + off_b(16 * s + 4 * hiv + q4v, ch) + 8 * (p4v & 1)); \
              const s16x4 hi4 = trd(ldb + SD_BS + off_b(16 * s + 8 + 4 * hiv + q4v, ch) + 8 * (p4v & 1)); \
              st = MFMA32(cat8(lo4, hi4), XN[s], st); \
          } } \
        if ((k) + 2 < NCH) SD_PREFETCH_X((k) + 2, XN); } while (0)
    SD_PREFETCH_B(0, pbA, laA, ldA, atA); SD_PREFETCH_X(0, xnA); SD_PREFETCH_B(1, pbB, laB, ldB, atB); SD_PREFETCH_X(1, xnB);
    SD_STEP(0, pbA, xnA, laA, ldA, atA);
    SD_STEP(1, pbB, xnB, laB, ldB, atB);
#pragma unroll 1
    for (int k = 2; k < NCH; k += 8) {
        SD_STEP(k, pbA, xnA, laA, ldA, atA); SD_STEP(k + 1, pbB, xnB, laB, ldB, atB);
        SD_STEP(k + 2, pbA, xnA, laA, ldA, atA); SD_STEP(k + 3, pbB, xnB, laB, ldB, atB);
        SD_STEP(k + 4, pbA, xnA, laA, ldA, atA); SD_STEP(k + 5, pbB, xnB, laB, ldB, atB);
        SD_STEP(k + 6, pbA, xnA, laA, ldA, atA); SD_STEP(k + 7, pbB, xnB, laB, ldB, atB);
    }
    __syncthreads();
#undef SD_STEP
#undef SD_CID
#undef SD_PREFETCH_B
#undef SD_PREFETCH_X
}
constexpr int SY_BS = 0, SY_CS = 32768, SY_LA = 65536, SY_BJ = SY_LA + 8192, SY_GX = SY_BJ + 8192;
template <int PMODE>
__device__ __forceinline__ void ssd_y_unit(const Args& A, lptr lds, int b, int c, int tid) {
    const int lane = tid & 63, w = __builtin_amdgcn_readfirstlane(tid >> 6), r32 = lane & 31, hi = lane >> 5, it = w >> 1, pt = w & 1;
    const bf16* BC = (const bf16*)(A.ws + WS_BC); const bf16* CC = (const bf16*)(A.ws + WS_CC); const bf16* XT = (const bf16*)(A.ws + WS_H);
    const bf16* HST = (const bf16*)(A.ws + WS_HST); bf16* ZQ = (bf16*)(A.ws + WS_ZQ); bf16* YT = (bf16*)(A.ws + WS_YTMP);
    const float* LA = (const float*)(A.ws + WS_LA); const float* LD = (const float*)(A.ws + WS_LD);
    const size_t tok0 = (size_t)b * SEQ + 128 * c;
    for (int g = 0; g < 2; ++g) {
#pragma unroll
        for (int i = 0; i < 4; ++i) { const int idx = tid + NTHR * i, row = idx >> 4, ch = idx & 15;
            const v4u vb_ = *(const GAS v4u*)(BC + (tok0 + row) * 256 + g * 128 + ch * 8);
            *(LAS v4u*)(lds + SY_BS + off_b(row, ch)) = vb_; }
        asm volatile("" ::: "memory");
#pragma unroll
        for (int i = 0; i < 4; ++i) { const int idx = tid + NTHR * i, row = idx >> 4, ch = idx & 15;
            const v4u vc_ = *(const GAS v4u*)(CC + (tok0 + row) * 256 + g * 128 + ch * 8);
            *(LAS v4u*)(lds + SY_CS + off_b(row, ch)) = vc_; }
        asm volatile("" ::: "memory");
#pragma unroll
        for (int i = 0; i < 4; ++i) { const int idx = tid + NTHR * i, combo = idx >> 7, t = idx & 127, dir = combo >> 3, hl = combo & 7;
            const size_t o = ((size_t)(b * 2 + dir) * 16 + g * 8 + hl) * (NCH * 128) + (2 + c) * 128 + t;
            const float la = LA[o], ld = LD[o];
            ((LAS float*)(lds + SY_LA))[combo * 128 + t] = la; ((LAS float*)(lds + SY_BJ))[combo * 128 + t] = la - ld; }
        WG_BAR();
        int r32v = r32, hiv = hi; asm volatile("" : "+v"(r32v), "+v"(hiv));
        lptr gpl = lds + (w < 4 ? SY_BS + w * 8192 : SY_GX + (w - 4) * 8192) + lane * 16;
        {
        v4u Gp[4][2];
        bf16x8 cf[8];
#pragma unroll
        for (int s = 0; s < 8; ++s) cf[s] = *(const LAS bf16x8*)(lds + SY_CS + off_b(32 * it + r32v, 2 * s + hiv));
#pragma unroll
        for (int jt = 0; jt < 4; ++jt) {
            f32x16 gt;
#pragma unroll
            for (int r = 0; r < 16; ++r) gt[r] = 0.f;
#pragma unroll
            for (int s = 0; s < 8; ++s) { const bf16x8 a = *(const LAS bf16x8*)(lds + SY_BS + off_b(32 * jt + r32v, 2 * s + hiv)); gt = MFMA32(a, cf[s], gt); }
#pragma unroll
            for (int j = 0; j < 4; ++j) { Gp[jt][0][j] = cvtpk(gt[2 * j], gt[2 * j + 1]); Gp[jt][1][j] = cvtpk(gt[8 + 2 * j], gt[8 + 2 * j + 1]); }
        }
        WG_BAR();
#pragma unroll
        for (int jt = 0; jt < 4; ++jt) { *(LAS v4u*)(gpl + (jt * 2) * 1024) = Gp[jt][0]; *(LAS v4u*)(gpl + (jt * 2 + 1) * 1024) = Gp[jt][1]; }
        }
        bf16x8 hs[8];
#define SY_HS_LOAD(dst, head_, dir_, pt_) do { const bf16* hp_ = HST + ((((size_t)b * 32 + c) * 16 + (head_)) * 2 + (dir_)) * (64 * 128) + (size_t)((pt_) * 8 * 64 + lane) * 8; \
            _Pragma("unroll") for (int s_ = 0; s_ < 8; ++s_) dst[s_] = (PMODE == 3) ? (bf16x8){1, 2, 3, 4, 5, 6, 7, (short)r32} : *(const GAS bf16x8*)(hp_ + s_ * 512); } while (0)
#define SY_YOFF(hs_, dir_, pt_) do { const LAS float* la_ = (const LAS float*)(lds + SY_LA) + ((dir_) * 8 + hl) * 128; f32x16 t_; \
            _Pragma("unroll") for (int r = 0; r < 16; ++r) t_[r] = 0.f; \
            _Pragma("unroll") for (int s = 0; s < 8; ++s) { const bf16x8 cfs = *(const LAS bf16x8*)(lds + SY_CS + off_b(32 * it + r32v, 2 * s + hiv)); t_ = MFMA32(cfs, hs_[s], t_); } \
            _Pragma("unroll") for (int g4 = 0; g4 < 4; ++g4) { const f32x4 a_ = *(const LAS f32x4*)(la_ + 32 * it + 8 * g4 + 4 * hiv); \
                _Pragma("unroll") for (int e = 0; e < 4; ++e) acc[pt_][4 * g4 + e] += t_[4 * g4 + e] * __builtin_amdgcn_exp2f(a_[e]); } } while (0)
#define SY_DIAG(dir) do { \
                const LAS float* la_s = (const LAS float*)(lds + SY_LA) + ((dir) * 8 + hl) * 128; const LAS float* bj_s = (const LAS float*)(lds + SY_BJ) + ((dir) * 8 + hl) * 128; \
                const float ai = la_s[32 * it + r32]; \
                _Pragma("unroll") for (int jt = 0; jt < 4; ++jt) { \
                    if ((dir) == 0 ? (jt <= it) : (jt >= it)) { \
                        float gv[16]; \
                        { const v4u g0 = *(const LAS v4u*)(gpl + (jt * 2) * 1024), g1 = *(const LAS v4u*)(gpl + (jt * 2 + 1) * 1024); \
                          _Pragma("unroll") for (int j = 0; j < 4; ++j) { gv[2 * j] = bflo(g0[j]); gv[2 * j + 1] = bfhi(g0[j]); gv[8 + 2 * j] = bflo(g1[j]); gv[8 + 2 * j + 1] = bfhi(g1[j]); } } \
                        { int dd = (jt == it) ? (r32v - 4 * hiv) : ((dir) == 0 ? 1000 : -1000); asm volatile("" : "+v"(dd));     \
                          _Pragma("unroll") for (int g4 = 0; g4 < 4; ++g4) { const f32x4 bq = *(const LAS f32x4*)(bj_s + 32 * jt + 8 * g4 + 4 * hiv); \
                            _Pragma("unroll") for (int e = 0; e < 4; ++e) { const int r = 4 * g4 + e, cr = e + 8 * g4; \
                                const bool valid = ((dir) == 0) ? (cr <= dd) : (cr >= dd); \
                                gv[r] *= __builtin_amdgcn_exp2f(valid ? (ai - bq[e]) : -10000.f); \
                                if ((dir) == 0) gv[r] += (cr == dd) ? dskip : 0.f; } } } \
                        v4u u0, u1; \
                        _Pragma("unroll") for (int j = 0; j < 4; ++j) { u0[j] = cvtpk(gv[2 * j], gv[2 * j + 1]); u1[j] = cvtpk(gv[8 + 2 * j], gv[8 + 2 * j + 1]); } \
                        _Pragma("unroll") for (int p2 = 0; p2 < 2; ++p2) { \
                            acc[p2] = MFMA32(__builtin_bit_cast(bf16x8, u0), xf[p2][2 * jt], acc[p2]); \
                            acc[p2] = MFMA32(__builtin_bit_cast(bf16x8, u1), xf[p2][2 * jt + 1], acc[p2]); } \
                    } } } while (0)
        const int hp = w & 1;
        SY_HS_LOAD(hs, 8 * g + hp, 0, 0);
        for (int hq = 0; hq < 4; ++hq) {
            const int hl = 2 * hq + hp, head = 8 * g + hl;
            asm volatile("" : "+v"(r32v), "+v"(hiv));
            bf16x8 xf[2][8];
#pragma unroll
            for (int p2 = 0; p2 < 2; ++p2) { const bf16* xp = XT + (((size_t)b * NCH + 2 + c) * 16 + head) * (64 * 128) + (size_t)(p2 * 8 * 64 + lane) * 8;
#pragma unroll
              for (int s = 0; s < 8; ++s) xf[p2][s] = (PMODE == 3) ? (bf16x8){1, 2, 3, 4, 5, 6, 7, (short)hi} : *(const GAS bf16x8*)(xp + s * 512); }
            const float dskip = A.in[15][head];
            f32x16 acc[2];
#pragma unroll
            for (int r = 0; r < 16; ++r) { acc[0][r] = 0.f; acc[1][r] = 0.f; }
            SY_YOFF(hs, 0, 0); __builtin_amdgcn_sched_barrier(0);
            SY_HS_LOAD(hs, head, 0, 1); __builtin_amdgcn_sched_barrier(0);
            if (PMODE != 2) SY_DIAG(0);
            __builtin_amdgcn_sched_barrier(0);
            SY_YOFF(hs, 0, 1); __builtin_amdgcn_sched_barrier(0);
            SY_HS_LOAD(hs, head, 1, 0); __builtin_amdgcn_sched_barrier(0);
            if (PMODE != 2) SY_DIAG(1);
            __builtin_amdgcn_sched_barrier(0);
            SY_YOFF(hs, 1, 0); __builtin_amdgcn_sched_barrier(0);
            SY_HS_LOAD(hs, head, 1, 1); __builtin_amdgcn_sched_barrier(0);
            SY_YOFF(hs, 1, 1); __builtin_amdgcn_sched_barrier(0);
            if (hq < 3) SY_HS_LOAD(hs, head + 2, 0, 0);
            __builtin_amdgcn_sched_barrier(0);
#pragma unroll
            for (int p2 = 0; p2 < 2; ++p2) { bf16* yp = YT + (tok0 + 32 * it) * 1024 + head * 64 + 32 * p2 + r32;
#pragma unroll
                for (int r = 0; r < 16; ++r) yp[(size_t)crow(r, hi) * 1024] = (bf16)(cvtpk(acc[p2][r], 0.f) & 0xffffu); }
        }
#undef SY_YOFF
#undef SY_DIAG
#undef SY_HS_LOAD
        WG_BAR();
    }
    __syncthreads();
    if (PMODE != 0) return;
    { const float* nw = A.in[16];
      f32x4 nwv[4];
#pragma unroll
      for (int j = 0; j < 2; ++j) { nwv[2 * j] = *(const f32x4*)(nw + 8 * lane + 512 * j); nwv[2 * j + 1] = *(const f32x4*)(nw + 8 * lane + 512 * j + 4); }
      for (int rq = 0; rq < 4; ++rq) {
        v4u yv[4][2], zv[4][2];
#pragma unroll
        for (int u = 0; u < 4; ++u) { const size_t row = tok0 + w * 16 + rq * 4 + u;
#pragma unroll
            for (int j = 0; j < 2; ++j) { const int cc = 8 * lane + 512 * j; yv[u][j] = *(const GAS v4u*)(YT + row * 1024 + cc); zv[u][j] = *(const GAS v4u*)(ZQ + row * 2048 + cc); } }
#pragma unroll
        for (int u = 0; u < 4; ++u) { const size_t row = tok0 + w * 16 + rq * 4 + u;
            float gv[16]; float s = 0.f;
#pragma unroll
            for (int j = 0; j < 2; ++j)
#pragma unroll
                for (int e = 0; e < 4; ++e) { const float g0 = bflo(yv[u][j][e]) * silu_f(bflo(zv[u][j][e])), g1 = bfhi(yv[u][j][e]) * silu_f(bfhi(zv[u][j][e])); gv[8 * j + 2 * e] = g0; gv[8 * j + 2 * e + 1] = g1; s += g0 * g0 + g1 * g1; }
            const float rstd = rsqrtf(wave_sum(s) * (1.f / 1024.f) + RMS_EPS);
#pragma unroll
            for (int j = 0; j < 2; ++j) { const int cc = 8 * lane + 512 * j; v4u o;
#pragma unroll
                for (int e = 0; e < 4; ++e) { const f32x4 wq = nwv[2 * j + (e >> 1)]; o[e] = cvtpk(gv[8 * j + 2 * e] * rstd * wq[(2 * e) & 3], gv[8 * j + 2 * e + 1] * rstd * wq[(2 * e + 1) & 3]); }
                *(GAS v4u*)(ZQ + row * 2048 + cc) = o; } } } }
    __syncthreads();
}
__device__ __forceinline__ void conv1_phase(const Args& A, int tid, int vcu, int G) {
    const bf16* P1 = (const bf16*)(A.ws + WS_P1); bf16* G1 = (bf16*)(A.ws + WS_G1); const float* cw = A.in[20];
    const int gt = vcu * NTHR + tid, NGT = G * NTHR;
    for (int item = gt; item < (M_LAT / 16) * 128; item += NGT) {
        const int rb = item >> 7, c0 = (item & 127) * 8, r0 = rb * 16, t0 = r0 & (SEQ - 1);
        float w[3][8];
#pragma unroll
        for (int k = 0; k < 3; ++k) { const f32x4 a = *(const f32x4*)(cw + k * 1024 + c0), b2 = *(const f32x4*)(cw + k * 1024 + c0 + 4);
#pragma unroll
            for (int e = 0; e < 4; ++e) { w[k][e] = a[e]; w[k][4 + e] = b2[e]; } }
        const bf16* src = P1 + (size_t)r0 * 2048 + c0;
        const v4u zero4 = {0u, 0u, 0u, 0u};
        v4u up = (t0 > 0) ? *(const GAS v4u*)(src - 2048 + 1024) : zero4, uc = *(const GAS v4u*)(src + 1024);
#pragma unroll
        for (int i = 0; i < 16; ++i) {
            const v4u un = (t0 + i + 1 < SEQ) ? *(const GAS v4u*)(src + (size_t)(i + 1) * 2048 + 1024) : zero4;
            const v4u gb = *(const GAS v4u*)(src + (size_t)i * 2048); v4u o;
#pragma unroll
            for (int e = 0; e < 4; ++e) { const float a0 = w[0][2 * e] * bflo(up[e]) + w[1][2 * e] * bflo(uc[e]) + w[2][2 * e] * bflo(un[e]);
                const float a1 = w[0][2 * e + 1] * bfhi(up[e]) + w[1][2 * e + 1] * bfhi(uc[e]) + w[2][2 * e + 1] * bfhi(un[e]);
                o[e] = cvtpk(bflo(gb[e]) * a0, bfhi(gb[e]) * a1); }
            *(GAS v4u*)(G1 + (size_t)(r0 + i) * 1024 + c0) = o;
            up = uc; uc = un;
        }
    }
}
#define MK_MODE 2
#define PROBE_DUP 0
#define STAGGER_US 0
constexpr int N_PHASES = 18;
__global__ void __launch_bounds__(NTHR, 2) mk_fwd(Args args) {
    extern __shared__ __attribute__((aligned(16))) unsigned char lds_raw[];
    lptr lds = (lptr)lds_raw;
    const int tid = threadIdx.x, G = gridDim.x;
    const int bx = blockIdx.x, vcu = (G % 8 == 0) ? (bx % 8) * (G / 8) + bx / 8 : bx;
    unsigned char* ws = args.ws;
    const int lo = args.ph_lo, hi = args.ph_hi;
    for (int u = tid; u < (LDS_BYTES - LDSCTL_OFF) / 4; u += NTHR) ((LAS unsigned*)(lds + LDSCTL_OFF))[u] = 0u;
    __syncthreads();
    XcdBarrier bar; bar.bar = (unsigned*)(ws + WS_CTL); bar.x = 0; bar.st = nullptr;
    if (hi - lo > 1 && !args.use_cg) bar = xcd_barrier_post((unsigned*)(ws + WS_CTL), (volatile LAS unsigned*)(lds + MISC_OFF) + 8);
#ifndef PROBE_DUP
#define PROBE_DUP 0
#endif
#ifndef MLPUP_SP2
#define MLPUP_SP2 true
#endif
#ifndef RES_ALIGN
#define RES_ALIGN true
#endif
#ifndef STAGGER_US
#define STAGGER_US 0
#endif
#ifndef PH_MASK
#define PH_MASK 0x3ffff
#endif
#define IN(k) (((PH_MASK >> (k)) & 1) && lo <= (k) && (k) < hi)
#define SEAM(k) do { if (IN(k) && IN((k) + 1)) { if (args.use_cg) { cg::this_grid().sync(); } else { xcd_barrier(bar); if (PROBE_DUP & 262144) xcd_barrier(bar); } } } while (0)
#define STAGGER(us) do { if ((us) > 0 && (vcu & 1)) { const unsigned long long t0_ = __builtin_amdgcn_s_memrealtime(); while (__builtin_amdgcn_s_memrealtime() - t0_ < (unsigned long long)(us) * 100ull) __builtin_amdgcn_s_sleep(16); } } while (0)
    bf16* XB = (bf16*)(ws + WS_XB);
    const float* MOD = (const float*)(ws + WS_MOD); const float* WSV = (const float*)(ws + WS_WSV); float* SSQ = (float*)(ws + WS_SSQ); const float* BIASB = (const float*)(ws + WS_BIASB);
    bf16* H = (bf16*)(ws + WS_H);

    if (IN(0)) { p0_prologue(args, lds, tid, vcu, G); } SEAM(0);
    if (IN(1)) { early_weights(args, lds, tid, vcu, G); norm_phase(args, args.in[0], args.in[6], 0, 0, true, tid, vcu, G); } SEAM(1);
    if (IN(2)) {
        pg8::Gemm g{H, (const bf16*)(ws + WS_WIN), M_ALL, NIN0, D}; pg8::InProjOrder S{G, bx};
        pg8::EpiInProj E{(bf16*)(ws + WS_XBC), (bf16*)(ws + WS_ZQ), (bf16*)(ws + WS_KV), (float*)(ws + WS_DTRAW)};
        for (int rep = 0; rep < ((PROBE_DUP & 256) ? 2 : 1); ++rep)
        pg8::gemm_phase<pg8::EpiInProj, pg8::InProjOrder, true, true>(lds, g, S, E);
    } SEAM(2);
    if (IN(3)) {
        if (bx == G - 1) wsv_phase(args, tid);
        if (PROBE_DUP & 1) for (int u = vcu; u < 256; u += G) na_group<0>(args, lds, u >> 5, (u >> 1) & 15, (u & 1) * 8, tid, (bf16*)args.out);
        if (PROBE_DUP & 8192) for (int u = vcu; u < 256; u += G) na_group<3>(args, lds, u >> 5, (u >> 1) & 15, (u & 1) * 8, tid, (bf16*)args.out);
        if (PROBE_DUP & 16384) for (int u = vcu; u < 256; u += G) na_group<4>(args, lds, u >> 5, (u >> 1) & 15, (u & 1) * 8, tid, (bf16*)args.out);
        if (PROBE_DUP & 524288) for (int u = vcu; u < 256; u += G) na_group<5>(args, lds, u >> 5, (u >> 1) & 15, (u & 1) * 8, tid, (bf16*)args.out);
        for (int u = vcu; u < 256; u += G) na_group<0>(args, lds, u >> 5, (u >> 1) & 15, (u & 1) * 8, tid, (bf16*)(ws + WS_ZQ));
        { const int wave = __builtin_amdgcn_readfirstlane(tid >> 6), lane = tid & 63, pq = bx & 7;
          unsigned* tk = (unsigned*)(ws + WS_TICKET) + 64 * pq;
          unsigned tv = 0u; if (lane == 0) tv = __hip_atomic_fetch_add(tk, 1u, __ATOMIC_RELAXED, __HIP_MEMORY_SCOPE_AGENT);
#define PREP_POS(t_) ((int)(((t_) >> 3) * 64u + 8u * (unsigned)pq + ((t_) & 7u)))
          int pos = PREP_POS(__builtin_amdgcn_readfirstlane(tv));
          while (pos < PREP_ITEMS) {
              unsigned tn = 0u; if (lane == 0) tn = __hip_atomic_fetch_add(tk, 1u, __ATOMIC_RELAXED, __HIP_MEMORY_SCOPE_AGENT);
              prep_item(args, lds + wave * PREP_WLDS, pos < BATCH * NCH ? PREP_XITEMS + pos : pos - BATCH * NCH, lane);
              pos = PREP_POS(__builtin_amdgcn_readfirstlane(tn));
          } }
#undef PREP_POS
    } SEAM(3);
    if (IN(4)) {
        if (PROBE_DUP & 4) for (int u = bx; u < 256; u += G) { const int b = u & 7, j = u >> 3; ssd_state_unit<0>(args, lds, b, j & 15, j >> 4, tid); }
        if (PROBE_DUP & 32768) for (int u = bx; u < 256; u += G) { const int b = u & 7, j = u >> 3; ssd_state_unit<1>(args, lds, b, j & 15, j >> 4, tid); }
        if (PROBE_DUP & 65536) for (int u = bx; u < 256; u += G) { const int b = u & 7, j = u >> 3; ssd_state_unit<2>(args, lds, b, j & 15, j >> 4, tid); }
        for (int u = bx; u < 256; u += G) { const int b = u & 7, j = u >> 3; ssd_state_unit<0>(args, lds, b, j & 15, j >> 4, tid); }
    } SEAM(4);
    if (IN(5)) {
        if (PROBE_DUP & 1024) for (int u = bx; u < 256; u += G) { const int b = u & 7, cch = u >> 3; ssd_y_unit<1>(args, lds, b, cch, tid); }
        if (PROBE_DUP & 2048) for (int u = bx; u < 256; u += G) { const int b = u & 7, cch = u >> 3; ssd_y_unit<2>(args, lds, b, cch, tid); }
        if (PROBE_DUP & 4096) for (int u = bx; u < 256; u += G) { const int b = u & 7, cch = u >> 3; ssd_y_unit<3>(args, lds, b, cch, tid); }
        for (int u = bx; u < 256; u += G) { const int b = u & 7, cch = u >> 3; ssd_y_unit<0>(args, lds, b, cch, tid); }
        __syncthreads(); late_weights(args, lds, tid, vcu, G);
    } SEAM(5);
    if (IN(6)) {
        pg8::Gemm g{(const bf16*)(ws + WS_ZQ), (const bf16*)(ws + WS_WOUT), M_LAT, D, 2 * D}; pg8::StaticOrder S; S.init(M_LAT, D, G, bx);
        pg8::EpiResid<true, true> E{args.in[0], XB, MOD + 2 * D, 6 * D, H, WSV, SSQ};
        pg8::gemm_phase<pg8::EpiResid<true, true>, pg8::StaticOrder, RES_ALIGN, true>(lds, g, S, E);
    } SEAM(6);
    if (IN(8)) {
        pg8::Gemm g{H, (const bf16*)(ws + WS_W1T0), M_LAT, DFF, D}; pg8::StaticOrder S; S.init(M_LAT, DFF, G, bx);
        pg8::EpiBf16Act<1, true> E{(bf16*)(ws + WS_HID), DFF, SSQ, BIASB, 4096};
        if (PROBE_DUP & 32) pg8::gemm_phase<pg8::EpiBf16Act<1, true>, pg8::StaticOrder, true, MLPUP_SP2>(lds, g, S, E);
        if (PROBE_DUP & 512) { pg8::EpiProbeAct<0> EP{(bf16*)(ws + WS_HID), DFF, SSQ, BIASB, 4096}; pg8::gemm_phase<pg8::EpiProbeAct<0>, pg8::StaticOrder, true, true>(lds, g, S, EP); }
        if (PROBE_DUP & 131072) { pg8::EpiProbeAct<1> EP{(bf16*)(ws + WS_DTRAW), DFF, SSQ, BIASB, 4096}; pg8::gemm_phase<pg8::EpiProbeAct<1>, pg8::StaticOrder, true, true>(lds, g, S, EP); }
        pg8::gemm_phase<pg8::EpiBf16Act<1, true>, pg8::StaticOrder, true, MLPUP_SP2>(lds, g, S, E);
    } SEAM(8);
    if (IN(9)) {
        pg8::Gemm g{(const bf16*)(ws + WS_HID), (const bf16*)(ws + WS_W2T0), M_LAT, D, DFF}; pg8::StaticOrder S; S.init(M_LAT, D, G, bx);
        pg8::EpiResid<true, false> E{XB, XB, MOD + 5 * D, 6 * D, H, WSV + 8 * 1024, SSQ + M_LAT};
        pg8::gemm_phase<pg8::EpiResid<true, false>, pg8::StaticOrder, RES_ALIGN, true>(lds, g, S, E);
    } SEAM(9);
    if (IN(11)) {
        pg8::Gemm g{H, (const bf16*)(ws + WS_SCIN), M_LAT, 3 * D, D}; pg8::StaticOrder S; S.init(M_LAT, 3 * D, G, bx);
        pg8::EpiScIn E{(bf16*)(ws + WS_P1), SSQ + M_LAT, BIASB + 8 * 4096, 4096};
        pg8::gemm_phase<pg8::EpiScIn, pg8::StaticOrder, true, true>(lds, g, S, E);
    } SEAM(11);
    if (IN(12)) { for (int rep = 0; rep < ((PROBE_DUP & 128) ? 2 : 1); ++rep) conv1_phase(args, tid, vcu, G); } SEAM(12);
    if (IN(13)) {
        pg8::Gemm g{(const bf16*)(ws + WS_G1), (const bf16*)(ws + WS_SCOUT), M_LAT, D, D}; pg8::StaticOrder S; S.init(M_LAT, D, G, bx);
        pg8::EpiResid<true, false> E{XB, XB, MOD + (size_t)8 * 6 * D + 2 * D, 6 * D, H, WSV + 16 * 1024, SSQ + 2 * M_LAT};
        pg8::gemm_phase<pg8::EpiResid<true, false>, pg8::StaticOrder, RES_ALIGN, true>(lds, g, S, E);
    } SEAM(13);
    if (IN(15)) {
        pg8::Gemm g{H, (const bf16*)(ws + WS_W1T1), M_LAT, DFF, D}; pg8::StaticOrder S; S.init(M_LAT, DFF, G, bx);
        pg8::EpiBf16Act<1, true> E{(bf16*)(ws + WS_HID), DFF, SSQ + 2 * M_LAT, BIASB + 2 * 8 * 4096, 4096};
        pg8::gemm_phase<pg8::EpiBf16Act<1, true>, pg8::StaticOrder, true, MLPUP_SP2>(lds, g, S, E);
    } SEAM(15);
    if (IN(16)) {
        pg8::Gemm g{(const bf16*)(ws + WS_HID), (const bf16*)(ws + WS_W2T1), M_LAT, D, DFF}; pg8::StaticOrder S; S.init(M_LAT, D, G, bx);
        pg8::EpiResidFinal E{XB, args.out, MOD + (size_t)8 * 6 * D + 5 * D, 6 * D, args.in[22], SSQ + 3 * M_LAT, (unsigned*)(ws + WS_PCNT)};
        pg8::gemm_phase<pg8::EpiResidFinal, pg8::StaticOrder, RES_ALIGN, true>(lds, g, S, E);
    }
#undef IN
#undef SEAM
}

#ifndef MK_MODE
#define MK_MODE 0
#endif
extern "C" void kernel_launch(void* const* d_in, const int* in_sizes, int n_in, void* d_out, int out_size, void* d_ws, size_t ws_size, hipStream_t stream) {
    static int grid = 0;
    if (grid == 0) {
        if (n_in != 23 || out_size != M_LAT * D || ws_size < WS_END) { fprintf(stderr, "kernel_launch: unexpected problem shape (n_in %d out %d ws %zu)\n", n_in, out_size, ws_size); grid = -1; return; }
        int dev = 0, cus = 0, per_cu = 0;
        if (hipGetDevice(&dev) != hipSuccess || hipDeviceGetAttribute(&cus, hipDeviceAttributeMultiprocessorCount, dev) != hipSuccess) { grid = -1; return; }
        if (hipFuncSetAttribute((const void*)mk_fwd, hipFuncAttributeMaxDynamicSharedMemorySize, LDS_BYTES) != hipSuccess) { fprintf(stderr, "kernel_launch: hipFuncSetAttribute failed\n"); grid = -1; return; }
        if (hipOccupancyMaxActiveBlocksPerMultiprocessor(&per_cu, (const void*)mk_fwd, NTHR, LDS_BYTES) != hipSuccess || per_cu < 1) { fprintf(stderr, "kernel_launch: occupancy query says %d\n", per_cu); per_cu = 1; }
        (void)hipGetLastError();
        grid = cus;
    }
    if (grid < 0) return;
    (void)hipMemsetAsync((char*)d_ws + WS_CTL, 0, CTL_ZERO_BYTES, stream);
    Args a{};
    for (int i = 0; i < 23; ++i) a.in[i] = (const float*)d_in[i];
    a.out = (float*)d_out; a.ws = (unsigned char*)d_ws;
#if MK_MODE == 0
    for (int p = 0; p < N_PHASES; ++p) { a.ph_lo = p; a.ph_hi = p + 1; a.use_cg = 0; hipLaunchKernelGGL(mk_fwd, dim3(grid), dim3(NTHR), LDS_BYTES, stream, a); }
#else
    a.ph_lo = 0; a.ph_hi = N_PHASES; a.use_cg = (MK_MODE == 1) ? 1 : 0;
    void* kargs[] = {&a};
    hipError_t e = hipLaunchCooperativeKernel((const void*)mk_fwd, dim3(grid), dim3(NTHR), kargs, LDS_BYTES, stream);
    if (e != hipSuccess) fprintf(stderr, "kernel_launch: cooperative launch failed: %s (grid %d)\n", hipGetErrorString(e), grid);
#endif
}
```
